# Optimizing an MI355X kernel written in HIP

```python
import jax, jax.numpy as jnp
from jax import lax
import numpy as np

D_MODEL = 1024
BATCH = 4
SEQ = 8192
DEPTH = 1

GRID_W = 64
CTX_LEN = 256
N_FOURIER_GROUPS = 4
FOURIER_GROUP_DIM = 128
FOURIER_WIDTH = N_FOURIER_GROUPS * FOURIER_GROUP_DIM
NA_HEADS = 8
HEAD_DIM = 64
NA_WIDTH = NA_HEADS * HEAD_DIM
IN_WIDTH = FOURIER_WIDTH + 3 * NA_WIDTH
WIN_ROWS = 8
WIN_COLS = 16
N_BRANCHES = 2
D_FF = 4 * D_MODEL
ROPE_THETA = 10000.0
NORM_EPS = 1e-6
N_MOD = 6

kernel_name = "hybrid_fourier_natten_dit_block"


def rms_norm(x, g):
    xf = x.astype(jnp.float32)
    y = xf * lax.rsqrt(jnp.mean(xf * xf, axis=-1, keepdims=True) + NORM_EPS)
    return (y * g.astype(jnp.float32)).astype(x.dtype)


def modulate(h, shift, scale):
    return h * (1 + scale) + shift


def ada_mod(cond, w, b):
    m = jax.nn.silu(cond) @ w + b
    return jnp.split(m, N_MOD, axis=-1)


def split_heads(a):
    return a.reshape(a.shape[0], a.shape[1], NA_HEADS, HEAD_DIM)


def split_projection(p):
    f = p[..., :FOURIER_WIDTH]
    q = p[..., FOURIER_WIDTH:FOURIER_WIDTH + NA_WIDTH]
    k = p[..., FOURIER_WIDTH + NA_WIDTH:FOURIER_WIDTH + 2 * NA_WIDTH]
    v = p[..., FOURIER_WIDTH + 2 * NA_WIDTH:]
    return f, split_heads(q), split_heads(k), split_heads(v)


def rope_1d(x, cos, sin):
    m = x.shape[-1] // 2
    x1, x2 = x[..., :m], x[..., m:]
    cos = cos[None, :, None, :]
    sin = sin[None, :, None, :]
    return jnp.concatenate([x1 * cos - x2 * sin, x1 * sin + x2 * cos], axis=-1)


def axial_rope(x):
    n_tok = x.shape[1]
    t = jnp.arange(n_tok)
    row = (t // GRID_W).astype(jnp.float32)
    col = (t % GRID_W).astype(jnp.float32)
    axis_dim = HEAD_DIM // 2
    inv_freq = ROPE_THETA ** (-jnp.arange(0, axis_dim, 2, dtype=jnp.float32) / axis_dim)
    ang_r = row[:, None] * inv_freq
    ang_c = col[:, None] * inv_freq
    xf = x.astype(jnp.float32)
    xr = rope_1d(xf[..., :axis_dim], jnp.cos(ang_r), jnp.sin(ang_r))
    xc = rope_1d(xf[..., axis_dim:], jnp.cos(ang_c), jnp.sin(ang_c))
    return jnp.concatenate([xr, xc], axis=-1).astype(x.dtype)


def fourier_mix(u):
    b, n, _ = u.shape
    ug = u.astype(jnp.float32).reshape(b, n, N_FOURIER_GROUPS, FOURIER_GROUP_DIM)
    y = jnp.fft.fft2(ug, axes=(1, 3), norm="ortho").real
    return y.reshape(b, n, FOURIER_WIDTH).astype(u.dtype)


def neighbourhood_attention(q, k, v, k_ctx, v_ctx, rpb):
    b, s, h, dh = q.shape
    rows = s // GRID_W
    kr = min(WIN_ROWS, rows)
    kc = WIN_COLS
    n_loc = kr * kc
    scale = dh ** -0.5
    qg = q.reshape(b, rows, GRID_W, h, dh)
    kg = k.reshape(b, rows, GRID_W, h, dh)
    vg = v.reshape(b, rows, GRID_W, h, dh)
    r = jnp.arange(rows)
    cc = jnp.arange(GRID_W)
    row_start = jnp.clip(r - kr // 2, 0, rows - kr)
    col_start = jnp.clip(cc - kc // 2, 0, GRID_W - kc)
    col_idx = col_start[:, None] + jnp.arange(kc)
    dc_idx = col_idx - cc[:, None] + (WIN_COLS - 1)
    dr_idx = row_start[:, None] + jnp.arange(kr) - r[:, None] + (WIN_ROWS - 1)

    def one_row(args):
        q_row, rs, dr = args
        k_rows = lax.dynamic_slice_in_dim(kg, rs, kr, axis=1)
        v_rows = lax.dynamic_slice_in_dim(vg, rs, kr, axis=1)
        k_win = k_rows[:, :, col_idx]
        v_win = v_rows[:, :, col_idx]
        bias = rpb[:, dr][:, :, dc_idx].transpose(0, 2, 1, 3)
        s_loc = (jnp.einsum('bqhd,brqchd->bhqrc', q_row, k_win).astype(jnp.float32) * scale
                 + bias[None].astype(jnp.float32))
        s_ctx = jnp.einsum('bqhd,bkhd->bhqk', q_row, k_ctx).astype(jnp.float32) * scale
        sc = jnp.concatenate([s_loc.reshape(b, h, GRID_W, n_loc), s_ctx], axis=-1)
        p = jax.nn.softmax(sc, axis=-1).astype(v.dtype)
        p_loc = p[..., :n_loc].reshape(b, h, GRID_W, kr, kc)
        p_ctx = p[..., n_loc:]
        return (jnp.einsum('bhqrc,brqchd->bqhd', p_loc, v_win)
                + jnp.einsum('bhqk,bkhd->bqhd', p_ctx, v_ctx))

    out = lax.map(one_row, (qg.transpose(1, 0, 2, 3, 4), row_start, dr_idx))
    return out.transpose(1, 0, 2, 3, 4).reshape(b, s, h * dh)


def context_attention(q, k, v):
    b, n, h, dh = q.shape
    s = jnp.einsum('bqhd,bkhd->bhqk', q, k).astype(jnp.float32) * dh ** -0.5
    p = jax.nn.softmax(s, axis=-1).astype(v.dtype)
    return jnp.einsum('bhqk,bkhd->bqhd', p, v).reshape(b, n, h * dh)


def gated_merge(h, y_four, y_attn, w_gate, w_fo, w_ao, w_o):
    gates = jax.nn.sigmoid(h @ w_gate)
    g_f, g_a = jnp.split(gates, N_BRANCHES, axis=-1)
    merged = g_f * (y_four @ w_fo) + g_a * (y_attn @ w_ao)
    return merged @ w_o


def sqrelu_mlp(h, w1, w2):
    a = jax.nn.relu(h @ w1)
    return (a * a) @ w2


def setup_inputs(seed: int = 0) -> dict:
    key = jax.random.key(seed)
    ks = jax.random.split(key, 20)
    nrm = lambda k, shape, s: jax.random.normal(k, shape, jnp.float32) * s
    return {
        "x": nrm(ks[0], (BATCH, SEQ, D_MODEL), 1.0),
        "c": nrm(ks[1], (BATCH, D_MODEL), 1.0),
        "ctx": nrm(ks[2], (BATCH, CTX_LEN, D_MODEL), 1.0),
        "c_ctx": nrm(ks[3], (D_MODEL,), 1.0),
        "w_ada": nrm(ks[4], (DEPTH, D_MODEL, N_MOD * D_MODEL), D_MODEL ** -0.5),
        "b_ada": nrm(ks[5], (DEPTH, N_MOD * D_MODEL), 0.02),
        "norm1_g": 1.0 + nrm(ks[6], (DEPTH, D_MODEL), 0.02),
        "norm2_g": 1.0 + nrm(ks[7], (DEPTH, D_MODEL), 0.02),
        "w_in": nrm(ks[8], (DEPTH, D_MODEL, IN_WIDTH), D_MODEL ** -0.5),
        "q_norm_g": 1.0 + nrm(ks[9], (DEPTH, HEAD_DIM), 0.02),
        "k_norm_g": 1.0 + nrm(ks[10], (DEPTH, HEAD_DIM), 0.02),
        "rpb": nrm(ks[11], (DEPTH, NA_HEADS, 2 * WIN_ROWS - 1, 2 * WIN_COLS - 1), 0.1),
        "w_branch_gate": nrm(ks[12], (DEPTH, D_MODEL, N_BRANCHES * D_MODEL), D_MODEL ** -0.5),
        "w_fourier_out": nrm(ks[13], (DEPTH, FOURIER_WIDTH, D_MODEL), FOURIER_WIDTH ** -0.5),
        "w_attn_out": nrm(ks[14], (DEPTH, NA_WIDTH, D_MODEL), NA_WIDTH ** -0.5),
        "w_out": nrm(ks[15], (DEPTH, D_MODEL, D_MODEL), D_MODEL ** -0.5),
        "w_mlp1": nrm(ks[16], (DEPTH, D_MODEL, D_FF), D_MODEL ** -0.5),
        "w_mlp2": nrm(ks[17], (DEPTH, D_FF, D_MODEL), D_FF ** -0.5),
    }


def reference(x, c, ctx, c_ctx, w_ada, b_ada, norm1_g, norm2_g, w_in, q_norm_g, k_norm_g,
              rpb, w_branch_gate, w_fourier_out, w_attn_out, w_out, w_mlp1, w_mlp2):
    h_ctx = ctx
    for l in range(DEPTH):
        last = l == DEPTH - 1
        sh1, sc1, g1, sh2, sc2, g2 = [m[:, None, :] for m in ada_mod(c, w_ada[l], b_ada[l])]
        csh1, csc1, cg1, csh2, csc2, cg2 = ada_mod(c_ctx, w_ada[l], b_ada[l])

        hc = modulate(rms_norm(h_ctx, norm1_g[l]), csh1, csc1)
        fc, qc, kc, vc = split_projection(hc @ w_in[l])
        kc = rms_norm(kc, k_norm_g[l])

        hx = modulate(rms_norm(x, norm1_g[l]), sh1, sc1)
        fx, qx, kx, vx = split_projection(hx @ w_in[l])
        qx = axial_rope(rms_norm(qx, q_norm_g[l]))
        kx = axial_rope(rms_norm(kx, k_norm_g[l]))
        y_four = fourier_mix(fx)
        y_attn = neighbourhood_attention(qx, kx, vx, kc, vc, rpb[l])
        mixed = gated_merge(hx, y_four, y_attn, w_branch_gate[l], w_fourier_out[l],
                            w_attn_out[l], w_out[l])
        x = x + g1 * mixed
        hx2 = modulate(rms_norm(x, norm2_g[l]), sh2, sc2)
        x = x + g2 * sqrelu_mlp(hx2, w_mlp1[l], w_mlp2[l])

        if not last:
            qc = rms_norm(qc, q_norm_g[l])
            yc_four = fourier_mix(fc)
            yc_attn = context_attention(qc, kc, vc)
            mixed_c = gated_merge(hc, yc_four, yc_attn, w_branch_gate[l], w_fourier_out[l],
                                  w_attn_out[l], w_out[l])
            h_ctx = h_ctx + cg1 * mixed_c
            hc2 = modulate(rms_norm(h_ctx, norm2_g[l]), csh2, csc2)
            h_ctx = h_ctx + cg2 * sqrelu_mlp(hc2, w_mlp1[l], w_mlp2[l])
    return x
```

```cpp
#include <hip/hip_runtime.h>
#include <hip/hip_cooperative_groups.h>
#include <cstdio>
namespace cg = cooperative_groups;
#ifndef N_LAUNCH_MODE
#define N_LAUNCH_MODE 1
#endif
namespace pg8 {
#define PG8_LAS __attribute__((address_space(3)))
typedef unsigned short bf16_t;
typedef short bf16x8 __attribute__((ext_vector_type(8)));
typedef float f32x4 __attribute__((ext_vector_type(4)));
typedef unsigned u32x4 __attribute__((ext_vector_type(4)));
constexpr int BM = 256, BK = 64, HALF = 128, HTB = HALF * BK * 2  , STAGE_BYTES = 8 * HTB, NXCD = 8, WGM = 8;

__host__ __device__ __forceinline__ int lds_byte(int r, int c) { const int st = (r >> 4) * 2 + (c >> 5), rr = r & 15, cc = c & 31, ob = rr * 64 + cc * 2; return st * 1024 + (ob ^ (((ob >> 9) & 1) << 5)); }
__host__ __device__ __forceinline__ void stage_rc(int b, int& R, int& C) { const int st = b / 1024, sb = b % 1024, swz = sb ^ (((sb >> 9) & 1) << 5); R = (st >> 1) * 16 + swz / 64; C = (st & 1) * 32 + (swz % 64) / 2; }
__host__ __device__ __forceinline__ int perm32(int rho) { const int n = rho >> 4, i = rho & 15; return 8 * (i >> 2) + 4 * n + (i & 3); }

struct Unit { int pm, pn, w; };
struct Gemm { const bf16_t* A; const bf16_t* Bt; const bf16_t* A2; const bf16_t* Bt2; int M, N, K, M2, N2; };

struct DualOrder {
    int nM[2], nN[2], nwg[2], G, c;
    __host__ __device__ void init(int M, int N, int M2, int N2, int G_, int c_) { nM[0] = M / BM; nN[0] = N / BM; nwg[0] = nM[0] * nN[0]; nM[1] = M2 / BM; nN[1] = N2 / BM; nwg[1] = nM[1] * nN[1]; G = G_; c = c_; }
    static __host__ __device__ __forceinline__ void map(int wgid, int nM_, int nN_, int nwg_, Unit& u) {
        { const int q = nwg_ / NXCD, r = nwg_ % NXCD, xcd = wgid % NXCD, off = wgid / NXCD; wgid = (xcd < r ? xcd * (q + 1) : r * (q + 1) + (xcd - r) * q) + off; }
        const int nig = WGM * nN_, gid = wgid / nig, fm = gid * WGM, gsz = (nM_ - fm) < WGM ? (nM_ - fm) : WGM;
        u.pm = fm + ((wgid % nig) % gsz); u.pn = (wgid % nig) / gsz;
    }
    __host__ __device__ bool next(int i, Unit& u) const {
        long L = (long)i * G + c;
        if (L < nwg[0]) { map((int)L, nM[0], nN[0], nwg[0], u); u.w = 0; return true; }
        L -= nwg[0];
        if (L < nwg[1]) { map((int)L, nM[1], nN[1], nwg[1], u); u.w = 1; return true; }
        return false;
    }
    __device__ __forceinline__ void a_ready(const Unit&) const {}
    __device__ __forceinline__ void done(const Unit&) const {}
};
__device__ __forceinline__ unsigned cvt_pk_bf16(float lo, float hi) { unsigned r; asm volatile("v_cvt_pk_bf16_f32 %0, %1, %2" : "=v"(r) : "v"(lo), "v"(hi)); return r; }
template <class Epi, class Sched, bool STAMP = false>
__device__ __forceinline__ void gemm_phase(PG8_LAS unsigned char* lds, const Gemm g, const Sched& S, const Epi& E, unsigned long long* stamps) {
    const int tid = threadIdx.x, wid = __builtin_amdgcn_readfirstlane(tid >> 6), lane = tid & 63, wr = wid >> 2, wc = wid & 3, fr = lane & 15, fq = lane >> 4;
    const int K = g.K, nt = K / BK;
    int ts_lo = 0, ts_hi = 0, nts = 0; const unsigned long long rt_entry = STAMP ? (unsigned long long)wall_clock64() : 0ull;
#define PG8_STAMP() do { if (STAMP && wid == 0 && nts < 64) { const unsigned long long _c = (unsigned long long)clock64(); \
        ts_lo = (lane == nts) ? (int)(unsigned)_c : ts_lo; ts_hi = (lane == nts) ? (int)(unsigned)(_c >> 32) : ts_hi; ++nts; } } while (0)
    PG8_STAMP();
    unsigned voffA[2], voffB[2];
#pragma unroll
    for (int i = 0; i < 2; ++i) { int R, C; stage_rc(tid * 16 + i * 8192, R, C); const int Rb = Epi::PERM ? ((R & ~31) + perm32(R & 31)) : R;
        voffA[i] = (unsigned)(R * K + C) * 2u; voffB[i] = (unsigned)(Rb * K + C) * 2u; }
    const size_t kstep = (size_t)(BK * 2);
    const size_t hstep = (size_t)HALF * K * 2;
    const size_t tstep = 2 * hstep;
    const unsigned ldsw = (unsigned)wid * 1024u;
    const int aoff = lds_byte(wr * 64 + fr, fq * 8), boff = lds_byte(wc * 32 + fr, fq * 8);
#define PG8_SA(b, h) (((b) * 2 + (h)) * HTB)
#define PG8_SB(b, h) ((4 + (b) * 2 + (h)) * HTB)
#define PG8_STAGE(bufoff, gbase, voff) do { _Pragma("unroll") for (int _i = 0; _i < 2; ++_i) \
        __builtin_amdgcn_global_load_lds((const unsigned*)((const char*)(gbase) + (voff)[_i]), (PG8_LAS unsigned*)(lds + (bufoff) + ldsw + _i * 8192), 16, 0, 0); } while (0)
#define PG8_LDA(dst, b, h) do { _Pragma("unroll") for (int m = 0; m < 4; ++m) _Pragma("unroll") for (int k = 0; k < 2; ++k) dst[m][k] = *(const PG8_LAS bf16x8*)(lds + PG8_SA(b, h) + aoff + m * 2048 + k * 1024); } while (0)
#define PG8_LDB(dst, b, h) do { _Pragma("unroll") for (int n = 0; n < 2; ++n) _Pragma("unroll") for (int k = 0; k < 2; ++k) dst[n][k] = *(const PG8_LAS bf16x8*)(lds + PG8_SB(b, h) + boff + n * 2048 + k * 1024); } while (0)
#define PG8_MMA(ai, bj, At, Bt) do { __builtin_amdgcn_s_setprio(1); _Pragma("unroll") for (int m = 0; m < 4; ++m) _Pragma("unroll") for (int n = 0; n < 2; ++n) _Pragma("unroll") for (int k = 0; k < 2; ++k) \
        acc[ai][bj][m][n] = __builtin_amdgcn_mfma_f32_16x16x32_bf16(Bt[n][k], At[m][k], acc[ai][bj][m][n], 0, 0, 0); __builtin_amdgcn_s_setprio(0); } while (0)
#define PG8_WAIT_V(n) asm volatile("s_waitcnt vmcnt(" #n ")" ::: "memory")
#define PG8_WAIT_L(n) asm volatile("s_waitcnt lgkmcnt(" #n ")" ::: "memory")
#define PG8_BAR __builtin_amdgcn_s_barrier()
#define PG8_SCHED __builtin_amdgcn_sched_barrier(0)
    Unit cur, nxt; int ui = 0;
    if (!S.next(0, cur)) return;
    f32x4 acc[2][2][4][2];
#pragma unroll
    for (int a = 0; a < 2; ++a)
#pragma unroll
        for (int b = 0; b < 2; ++b)
#pragma unroll
            for (int m = 0; m < 4; ++m)
#pragma unroll
                for (int n = 0; n < 2; ++n) acc[a][b][m][n] = (f32x4){0.f, 0.f, 0.f, 0.f};
    bf16x8 At[4][2], B0[2][2], B1[2][2];
    const char* cA = (const char*)(cur.w ? g.A2 : g.A) + (size_t)cur.pm * tstep; const char* cB = (const char*)(cur.w ? g.Bt2 : g.Bt) + (size_t)cur.pn * tstep;
    S.a_ready(cur);
    PG8_STAGE(PG8_SB(0, 0), cB, voffB); PG8_STAGE(PG8_SA(0, 0), cA, voffA); PG8_STAGE(PG8_SB(0, 1), cB + hstep, voffB); PG8_STAGE(PG8_SA(0, 1), cA + hstep, voffA);
    if (wr == 1) PG8_BAR;
    PG8_WAIT_V(4); PG8_BAR;
    PG8_STAGE(PG8_SB(1, 0), cB + kstep, voffB); PG8_STAGE(PG8_SA(1, 0), cA + kstep, voffA); PG8_STAGE(PG8_SB(1, 1), cB + hstep + kstep, voffB);
    PG8_WAIT_V(6); PG8_BAR;
    PG8_STAMP();
    for (;;) {
        const bool has_next = S.next(ui + 1, nxt);
        const char* nA = has_next ? (const char*)(nxt.w ? g.A2 : g.A) + (size_t)nxt.pm * tstep : cA; const char* nB = has_next ? (const char*)(nxt.w ? g.Bt2 : g.Bt) + (size_t)nxt.pn * tstep : cB;
        for (int t = 0; t < nt; t += 2) {
            const bool last = (t == nt - 2);
            const char* a1 = cA + (size_t)(t + 1) * kstep;
            const char* a2 = last ? nA : cA + (size_t)(t + 2) * kstep; const char* b2 = last ? nB : cB + (size_t)(t + 2) * kstep;
            const char* a3 = a2 + kstep; const char* b3 = b2 + kstep;
            if (last && has_next) S.a_ready(nxt);
            PG8_LDB(B0, 0, 0); PG8_SCHED; PG8_LDA(At, 0, 0); PG8_STAGE(PG8_SA(1, 1), a1 + hstep, voffA);
            PG8_WAIT_L(8); PG8_BAR; PG8_WAIT_L(0); PG8_MMA(0, 0, At, B0); PG8_BAR; PG8_SCHED;
            PG8_LDB(B1, 0, 1); PG8_STAGE(PG8_SB(0, 0), b2, voffB);
            PG8_BAR; PG8_WAIT_L(0); PG8_MMA(0, 1, At, B1); PG8_BAR;
            PG8_LDA(At, 0, 1); PG8_STAGE(PG8_SA(0, 0), a2, voffA);
            PG8_BAR; PG8_WAIT_L(0); PG8_MMA(1, 0, At, B0); PG8_BAR; PG8_SCHED;
            PG8_STAGE(PG8_SB(0, 1), b2 + hstep, voffB);
            PG8_WAIT_V(6); PG8_BAR; PG8_MMA(1, 1, At, B1); PG8_BAR;
            PG8_LDB(B0, 1, 0); PG8_SCHED; PG8_LDA(At, 1, 0); PG8_STAGE(PG8_SA(0, 1), a2 + hstep, voffA);
            PG8_WAIT_L(8); PG8_BAR; PG8_WAIT_L(0); PG8_MMA(0, 0, At, B0); PG8_BAR; PG8_SCHED;
            PG8_LDB(B1, 1, 1); PG8_STAGE(PG8_SB(1, 0), b3, voffB);
            PG8_BAR; PG8_WAIT_L(0); PG8_MMA(0, 1, At, B1); PG8_BAR;
            PG8_LDA(At, 1, 1); PG8_STAGE(PG8_SA(1, 0), a3, voffA);
            PG8_BAR; PG8_WAIT_L(0); PG8_MMA(1, 0, At, B0); PG8_BAR; PG8_SCHED;
            PG8_STAGE(PG8_SB(1, 1), b3 + hstep, voffB);
            PG8_WAIT_V(6); PG8_BAR; PG8_MMA(1, 1, At, B1); PG8_BAR;
        }
        PG8_STAMP();
        if constexpr (!Epi::AFTER_DRAIN) { E(acc, cur, wr, wc, fr, fq); S.done(cur); }
        PG8_STAMP();
        if (!has_next) break;
#pragma unroll
        for (int a = 0; a < 2; ++a)
#pragma unroll
            for (int b = 0; b < 2; ++b)
#pragma unroll
                for (int m = 0; m < 4; ++m)
#pragma unroll
                    for (int n = 0; n < 2; ++n) acc[a][b][m][n] = (f32x4){0.f, 0.f, 0.f, 0.f};
        cur = nxt; cA = nA; cB = nB; ++ui;
    }
    PG8_WAIT_V(0);
    if (wr == 0) PG8_BAR;
    PG8_BAR;
    if constexpr (Epi::AFTER_DRAIN) { E.fused(acc, cur, wr, wc, fr, fq, lds, wid, lane); S.done(cur); }
    PG8_STAMP();
    if (STAMP && wid == 0) { stamps[lane] = lane < nts ? (((unsigned long long)(unsigned)ts_hi << 32) | (unsigned)ts_lo) : 0ull;
        if (lane == 62) stamps[62] = rt_entry; if (lane == 63) stamps[63] = (unsigned long long)wall_clock64(); }
#undef PG8_STAMP
#undef PG8_SA
#undef PG8_SB
#undef PG8_STAGE
#undef PG8_LDA
#undef PG8_LDB
#undef PG8_MMA
#undef PG8_WAIT_V
#undef PG8_WAIT_L
#undef PG8_BAR
#undef PG8_SCHED
}
}

#define LAS __attribute__((address_space(3)))
typedef unsigned short u16;
typedef short bf16x8 __attribute__((ext_vector_type(8)));
typedef float f32x4 __attribute__((ext_vector_type(4)));
typedef float f32x16 __attribute__((ext_vector_type(16)));
typedef unsigned u32x4 __attribute__((ext_vector_type(4)));
typedef unsigned u32x2 __attribute__((ext_vector_type(2)));
typedef __bf16 bf16x2_t __attribute__((ext_vector_type(2)));
typedef float f32x2_t __attribute__((ext_vector_type(2)));
#define DI __device__ __forceinline__

DI unsigned pk2(float a, float b) { f32x2_t v = {a, b}; return __builtin_bit_cast(unsigned, __builtin_convertvector(v, bf16x2_t)); }
DI u16 f2bf(float a) { return (u16)(pk2(a, 0.f) & 0xffffu); }
DI float bflo(unsigned u) { return __uint_as_float(u << 16); }
DI float bfhi(unsigned u) { return __uint_as_float(u & 0xffff0000u); }
DI u32x4 pack8(const float* v) { u32x4 r; r[0] = pk2(v[0], v[1]); r[1] = pk2(v[2], v[3]); r[2] = pk2(v[4], v[5]); r[3] = pk2(v[6], v[7]); return r; }
DI float wave_sum(float v) { v += __shfl_xor(v, 32); v += __shfl_xor(v, 16); v += __shfl_xor(v, 8); v += __shfl_xor(v, 4); v += __shfl_xor(v, 2); v += __shfl_xor(v, 1); return v; }
#define MFMA32(a, b, c) __builtin_amdgcn_mfma_f32_32x32x16_bf16((a), (b), (c), 0, 0, 0)

constexpr int NB = 4, SEQ = 8192, DM = 1024, CTXL = 256, MTOK = NB * SEQ, MCTX = NB * CTXL, DFF = 4096;
constexpr size_t MB = 1u << 20, KB = 1024;
constexpr size_t WS_WIN = 0, WS_WGATE = 4 * MB, WS_WFO = 8 * MB, WS_WAO = 10 * MB, WS_WO = 11 * MB, WS_W1 = 13 * MB, WS_W2 = 21 * MB,
    WS_ADA = 29 * MB, WS_ROPE = 29 * MB + 128 * KB, WS_TW = 29 * MB + 144 * KB, WS_F1 = 29 * MB + 208 * KB, WS_F2 = 29 * MB + 224 * KB,
    WS_QKG = 29 * MB + 352 * KB, WS_CTXK = 30 * MB, WS_CTXV = 31 * MB, WS_HC = 32 * MB,
    WS_F = 64 * MB, WS_Q = 96 * MB, WS_K = 128 * MB, WS_V = 160 * MB, WS_T1 = 192 * MB, WS_Z = 256 * MB,
    WS_GATES = 64 * MB, WS_YF = 192 * MB, WS_A = 64 * MB, WS_HX = 320 * MB, WS_MERGED = 320 * MB, WS_YATT = 384 * MB, WS_END = 416 * MB;
constexpr int LDS_BYTES = 147456;
constexpr int N_PHASES = 11;
#ifndef ONLY_PH
#define ONLY_PH -1
#endif
#define EN(x) (ONLY_PH < 0 || ONLY_PH == (x))

struct Params { const float* in[18]; float* out; unsigned char* ws; int ph_lo, ph_hi; };

DI int win_src_col(int R) {
    const int pn = R >> 8, cc = R & 255;
    if (pn < 2) return R;
    const int kind = pn >> 1, head = 4 * (pn & 1) + ((cc & 127) >> 5), bj = cc >> 7, t = cc & 31;
    int dim;
    if (kind == 3) dim = 32 * bj + t;
    else { const int fq = t >> 3, e = t & 7; dim = 32 * bj + 16 * (e >> 2) + 4 * fq + (e & 3); }
    return 512 * kind + 64 * head + dim;
}
DI int p16(int o) { return 8 * ((o >> 2) & 1) + 4 * (o >> 3) + (o & 3); }

struct EpiWin {
    static constexpr bool PERM = true, AFTER_DRAIN = false;
    unsigned char* ws; LAS unsigned char* xl;
    __device__ __forceinline__ void operator()(const f32x4 (&acc)[2][2][4][2], const pg8::Unit& u, int wr, int wc, int fr, int fq) const {
        const int ctx = u.w;
        u16* const F = (u16*)(ws + WS_F); const float2* const rope = (const float2*)(ws + WS_ROPE);
        const int kind = ctx ? 2 + (u.pn >> 1) : (u.pn >> 1);
        const int lstok = ctx ? 8 : 13, stok = 1 << lstok;
        const int rowb = u.pm * 256 + wr * 64 + fr;
        if (kind == 0) {
#pragma unroll
            for (int ai = 0; ai < 2; ++ai)
#pragma unroll
                for (int m = 0; m < 4; ++m) { const int r = rowb + ai * 128 + m * 16;
#pragma unroll
                    for (int bj = 0; bj < 2; ++bj) { const int c0 = u.pn * 256 + bj * 128 + wc * 32 + fq * 8;
                        u32x4 o; o[0] = pk2(acc[ai][bj][m][0][0], acc[ai][bj][m][0][1]); o[1] = pk2(acc[ai][bj][m][0][2], acc[ai][bj][m][0][3]);
                        o[2] = pk2(acc[ai][bj][m][1][0], acc[ai][bj][m][1][1]); o[3] = pk2(acc[ai][bj][m][1][2], acc[ai][bj][m][1][3]);
                        *(u32x4*)(F + (size_t)r * 512 + c0) = o; } }
        } else if (kind == 3) {
            const int hh = 4 * (u.pn & 1) + wc, pp = p16(fr), lane = fq * 16 + fr;
            LAS u16* vl = (LAS u16*)(xl) + (wr * 4 + wc) * 1024;
            u16* vdst = (u16*)(ws + (ctx ? WS_CTXV : WS_V));
#pragma unroll
            for (int ai = 0; ai < 2; ++ai)
#pragma unroll
                for (int m = 0; m < 4; ++m) { const int r0 = u.pm * 256 + wr * 64 + ai * 128 + m * 16, b = r0 >> lstok, t0 = r0 & (stok - 1);
#pragma unroll
                    for (int bj = 0; bj < 2; ++bj)
#pragma unroll
                        for (int e = 0; e < 8; ++e) vl[(32 * bj + 8 * fq + e) * 16 + pp] = f2bf(acc[ai][bj][m][e >> 2][e & 3]);
                    const u32x4 a0 = *(const LAS u32x4*)(vl + lane * 16), a1 = *(const LAS u32x4*)(vl + lane * 16 + 8);
                    u16* o = vdst + ((size_t)(b * 8 + hh) * 64 + lane) * stok + t0;
                    *(u32x4*)(o) = a0; *(u32x4*)(o + 8) = a1; }
        } else {
            const float* gsrc = (const float*)(ws + WS_QKG) + (kind == 1 ? 0 : 64); u16* dst = (u16*)(ws + (kind == 1 ? WS_Q : (ctx ? WS_CTXK : WS_K)));
            const int hh = 4 * (u.pn & 1) + wc;
            float gv[2][8];
#pragma unroll
            for (int bj = 0; bj < 2; ++bj)
#pragma unroll
                for (int e = 0; e < 8; ++e) gv[bj][e] = gsrc[32 * bj + 16 * (e >> 2) + 4 * fq + (e & 3)];
#pragma unroll
            for (int ai = 0; ai < 2; ++ai)
#pragma unroll
                for (int m = 0; m < 4; ++m) { __builtin_amdgcn_sched_barrier(0); const int r = rowb + ai * 128 + m * 16, b = r >> lstok, t = r & (stok - 1);
                    float v[2][8]; float ss = 0.f;
#pragma unroll
                    for (int bj = 0; bj < 2; ++bj)
#pragma unroll
                        for (int e = 0; e < 8; ++e) { v[bj][e] = acc[ai][bj][m][e >> 2][e & 3]; ss += v[bj][e] * v[bj][e]; }
                    ss += __shfl_xor(ss, 16); ss += __shfl_xor(ss, 32);
                    const float rstd = __builtin_amdgcn_rsqf(ss * (1.f / 64.f) + 1e-6f);
#pragma unroll
                    for (int bj = 0; bj < 2; ++bj)
#pragma unroll
                        for (int e = 0; e < 8; ++e) v[bj][e] *= rstd * gv[bj][e];
                    if (!ctx) {
#pragma unroll
                        for (int bj = 0; bj < 2; ++bj) { const int pos = bj == 0 ? (t >> 6) : (t & 63);
                            const float4 cs0 = *(const float4*)(rope + pos * 16 + 4 * fq), cs1 = *(const float4*)(rope + pos * 16 + 4 * fq + 2);
                            const float cc[4] = {cs0.x, cs0.z, cs1.x, cs1.z}, sn[4] = {cs0.y, cs0.w, cs1.y, cs1.w};
#pragma unroll
                            for (int e = 0; e < 4; ++e) { const float x1 = v[bj][e], x2 = v[bj][e + 4]; v[bj][e] = x1 * cc[e] - x2 * sn[e]; v[bj][e + 4] = x1 * sn[e] + x2 * cc[e]; } }
                    }
                    u16* o = dst + ((size_t)(b * 8 + hh) * stok + t) * 64 + fq * 8;
                    *(u32x4*)(o) = pack8(v[0]); *(u32x4*)(o + 32) = pack8(v[1]); }
        }
    }
};
struct EpiGates {
    static constexpr bool PERM = true, AFTER_DRAIN = false;
    u16* G;
    __device__ __forceinline__ void operator()(const f32x4 (&acc)[2][2][4][2], const pg8::Unit& u, int wr, int wc, int fr, int fq) const {
        const int rowb = u.pm * 256 + wr * 64 + fr;
#pragma unroll
        for (int ai = 0; ai < 2; ++ai)
#pragma unroll
            for (int m = 0; m < 4; ++m) { const int r = rowb + ai * 128 + m * 16;
#pragma unroll
                for (int bj = 0; bj < 2; ++bj) { __builtin_amdgcn_sched_barrier(0); const int c0 = u.pn * 256 + bj * 128 + wc * 32 + fq * 8; float v[8];
#pragma unroll
                    for (int e = 0; e < 8; ++e) v[e] = __builtin_amdgcn_rcpf(1.f + __builtin_amdgcn_exp2f(-1.4426950408889634f * acc[ai][bj][m][e >> 2][e & 3]));
                    *(u32x4*)(G + (size_t)r * 2048 + c0) = pack8(v); } }
    }
};
struct EpiP5 {
    static constexpr bool PERM = true, AFTER_DRAIN = false;
    u16* G; u16* Y;
    __device__ __forceinline__ void operator()(const f32x4 (&acc)[2][2][4][2], const pg8::Unit& u, int wr, int wc, int fr, int fq) const {
        const int rowb = u.pm * 256 + wr * 64 + fr;
        const bool sg = u.w == 0; u16* O = sg ? G : Y; const int ldc = sg ? 2048 : 1024;
#pragma unroll
        for (int ai = 0; ai < 2; ++ai)
#pragma unroll
            for (int m = 0; m < 4; ++m) { const int r = rowb + ai * 128 + m * 16;
#pragma unroll
                for (int bj = 0; bj < 2; ++bj) { const int c0 = u.pn * 256 + bj * 128 + wc * 32 + fq * 8; float v[8];
#pragma unroll
                    for (int e = 0; e < 8; ++e) { const float a = acc[ai][bj][m][e >> 2][e & 3]; const float sgm = __builtin_amdgcn_rcpf(1.f + __builtin_amdgcn_exp2f(-1.4426950408889634f * a)); v[e] = sg ? sgm : a; }
                    *(u32x4*)(O + (size_t)r * ldc + c0) = pack8(v); } }
    }
};
template <int ACT> struct EpiBf16 {
    static constexpr bool PERM = true, AFTER_DRAIN = false;
    u16* O; int ldc;
    __device__ __forceinline__ void operator()(const f32x4 (&acc)[2][2][4][2], const pg8::Unit& u, int wr, int wc, int fr, int fq) const {
        const int rowb = u.pm * 256 + wr * 64 + fr;
#pragma unroll
        for (int ai = 0; ai < 2; ++ai)
#pragma unroll
            for (int m = 0; m < 4; ++m) { const int r = rowb + ai * 128 + m * 16;
#pragma unroll
                for (int bj = 0; bj < 2; ++bj) { const int c0 = u.pn * 256 + bj * 128 + wc * 32 + fq * 8; float v[8];
#pragma unroll
                    for (int e = 0; e < 8; ++e) { float a = acc[ai][bj][m][e >> 2][e & 3]; if (ACT == 1) { a = fmaxf(a, 0.f); a = a * a; } v[e] = a; }
                    *(u32x4*)(O + (size_t)r * ldc + c0) = pack8(v); } }
    }
};
struct EpiMerge {
    static constexpr bool PERM = true, AFTER_DRAIN = false;
    const u16* G; const u16* YF; u16* O;
    __device__ __forceinline__ void operator()(const f32x4 (&acc)[2][2][4][2], const pg8::Unit& u, int wr, int wc, int fr, int fq) const {
        const int rowb = u.pm * 256 + wr * 64 + fr;
#pragma unroll
        for (int ai = 0; ai < 2; ++ai)
#pragma unroll
            for (int m = 0; m < 4; ++m) { const int r = rowb + ai * 128 + m * 16;
#pragma unroll
                for (int bj = 0; bj < 2; ++bj) { const int c0 = u.pn * 256 + bj * 128 + wc * 32 + fq * 8;
                    const u32x4 gf = *(const u32x4*)(G + (size_t)r * 2048 + c0), ga = *(const u32x4*)(G + (size_t)r * 2048 + 1024 + c0), yf = *(const u32x4*)(YF + (size_t)r * 1024 + c0);
                    float v[8];
#pragma unroll
                    for (int q = 0; q < 4; ++q) { v[2 * q] = bflo(gf[q]) * bflo(yf[q]) + bflo(ga[q]) * acc[ai][bj][m][q >> 1][(2 * q) & 3];
                        v[2 * q + 1] = bfhi(gf[q]) * bfhi(yf[q]) + bfhi(ga[q]) * acc[ai][bj][m][q >> 1][(2 * q + 1) & 3]; }
                    *(u32x4*)(O + (size_t)r * 1024 + c0) = pack8(v); } }
    }
};
struct EpiResid {
    static constexpr bool PERM = true, AFTER_DRAIN = false;
    const float* base; float* out; const float* gate;
    __device__ __forceinline__ void operator()(const f32x4 (&acc)[2][2][4][2], const pg8::Unit& u, int wr, int wc, int fr, int fq) const {
        const int rowb = u.pm * 256 + wr * 64 + fr;
#pragma unroll
        for (int ai = 0; ai < 2; ++ai)
#pragma unroll
            for (int m = 0; m < 4; ++m) { const int r = rowb + ai * 128 + m * 16, b = r >> 13;
#pragma unroll
                for (int bj = 0; bj < 2; ++bj) { const int c0 = u.pn * 256 + bj * 128 + wc * 32 + fq * 8;
#pragma unroll
                    for (int n = 0; n < 2; ++n) { const f32x4 x = *(const f32x4*)(base + (size_t)r * 1024 + c0 + 4 * n), g = *(const f32x4*)(gate + b * 6144 + c0 + 4 * n);
                        *(f32x4*)(out + (size_t)r * 1024 + c0 + 4 * n) = x + g * acc[ai][bj][m][n]; } } }
    }
};

template <class Epi> DI void run_gemm2(LAS unsigned char* lds, const u16* A, const u16* Bt, int M, int N, const u16* A2, const u16* Bt2, int M2, int N2, int K, const Epi& E) {
    pg8::Gemm g; g.A = A; g.Bt = Bt; g.M = M; g.N = N; g.K = K; g.A2 = A2; g.Bt2 = Bt2; g.M2 = M2; g.N2 = N2;
    pg8::DualOrder S; S.init(M, N, M2, N2, (int)gridDim.x, (int)blockIdx.x);
    pg8::gemm_phase<Epi, pg8::DualOrder, false>(lds, g, S, E, nullptr);
}
template <class Epi> DI void run_gemm(LAS unsigned char* lds, const u16* A, const u16* Bt, int M, int N, int K, const Epi& E) { run_gemm2(lds, A, Bt, M, N, A, Bt, 0, 0, K, E); }

DI void phase_prep(const Params& p, unsigned char* smem) {
    float* sm = (float*)smem;
    float* sl = sm; float* red = sm + 5120; float* ctab = sm + 7680; float* tl = sm + 8192;
    const int tid = threadIdx.x;
    unsigned char* ws = p.ws;
    for (int i = tid; i < 5120; i += 512) { const int v = i >> 10, k = i & 1023; const float cv = v < 4 ? p.in[1][v * 1024 + k] : p.in[3][k]; sl[i] = cv / (1.f + __expf(-cv)); }
    if (tid < 128) ctab[tid] = cospif((float)tid * (1.f / 64.f));
    if (blockIdx.x == 0 && tid < 128) ((float*)(ws + WS_QKG))[tid] = tid < 64 ? p.in[9][tid] : p.in[10][tid - 64];
    __syncthreads();
    float* ada = (float*)(ws + WS_ADA);
    for (int item = blockIdx.x; item < 256; item += gridDim.x) {
        const int jj = tid % 24, kc = tid / 24, j = item * 24 + jj;
        if (kc < 21) { float a[5] = {0.f, 0.f, 0.f, 0.f, 0.f}; const int k1 = min(1024, kc * 49 + 49);
            for (int k = kc * 49; k < k1; ++k) { const float w = p.in[4][(size_t)k * 6144 + j];
#pragma unroll
                for (int v = 0; v < 5; ++v) a[v] += sl[v * 1024 + k] * w; }
#pragma unroll
            for (int v = 0; v < 5; ++v) red[(v * 21 + kc) * 24 + jj] = a[v]; }
        __syncthreads();
        if (tid < 120) { const int v = tid / 24, j2 = tid % 24; float s = 0.f; for (int q = 0; q < 21; ++q) s += red[(v * 21 + q) * 24 + j2]; ada[v * 6144 + item * 24 + j2] = s + p.in[5][item * 24 + j2]; }
        __syncthreads();
    }
    { float2* rope = (float2*)(ws + WS_ROPE); float2* tw = (float2*)(ws + WS_TW); u16* F1 = (u16*)(ws + WS_F1); u16* F2 = (u16*)(ws + WS_F2);
      for (int i = blockIdx.x * 512 + tid; i < 83968; i += gridDim.x * 512) {
          if (i < 2048) { const int pos = i >> 4, jf = i & 15; const float invf = powf(10000.f, -(float)jf * (1.f / 16.f)); const float ang = (float)pos * invf; rope[i] = make_float2(cosf(ang), sinf(ang)); }
          else if (i < 10240) { const int q = i - 2048; const float a = (float)q * (1.f / 4096.f); tw[q] = make_float2(cospif(a), sinpif(a)); }
          else if (i < 18432) { const int q = i - 10240, r = q >> 6, n2 = q & 63, k2 = r & 63; const float a = (float)((k2 * n2) & 63) * (1.f / 32.f); F1[q] = f2bf(r < 64 ? cospif(a) : -sinpif(a)); }
          else { const int q = i - 18432, r = q >> 8, cidx = q & 255, k1 = r & 127, n1 = cidx & 127; const float a = (float)((k1 * n1) & 127) * (1.f / 64.f);
                 const float C = cospif(a), S = sinpif(a); float v; if (r < 128) v = cidx < 128 ? C : S; else v = cidx < 128 ? -S : C; F2[q] = f2bf(v); }
      } }
    { u16* dst = (u16*)(ws + WS_WFO); const float* wfo = p.in[13];
      for (int item = blockIdx.x; item < 128; item += gridDim.x) {
          const int g = item >> 5, jblk = (item >> 1) & 15, half = item & 1, j = jblk * 64 + (tid & 63), kc = half * 8 + (tid >> 6);
          float ac[8], as[8];
#pragma unroll
          for (int e = 0; e < 8; ++e) { ac[e] = 0.f; as[e] = 0.f; }
          for (int kp = 0; kp < 128; ++kp) { const float w = wfo[(size_t)(g * 128 + kp) * 1024 + j];
#pragma unroll
              for (int e = 0; e < 8; ++e) { const int idx = ((kc * 8 + e) * kp) & 127; ac[e] += ctab[idx] * w; as[e] += ctab[(idx - 32) & 127] * w; } }
          *(u32x4*)(dst + (size_t)j * 1024 + g * 128 + kc * 8) = pack8(ac);
          *(u32x4*)(dst + (size_t)j * 1024 + 512 + g * 128 + kc * 8) = pack8(as);
      } }
    for (int ti = blockIdx.x; ti < 3456; ti += gridDim.x) {
        const float* src; u16* dst; int K, N, tl_i, map = 0;
        if (ti < 512) { src = p.in[8]; dst = (u16*)(ws + WS_WIN); K = 1024; N = 2048; tl_i = ti; map = 1; }
        else if (ti < 1024) { src = p.in[12]; dst = (u16*)(ws + WS_WGATE); K = 1024; N = 2048; tl_i = ti - 512; }
        else if (ti < 1152) { src = p.in[14]; dst = (u16*)(ws + WS_WAO); K = 512; N = 1024; tl_i = ti - 1024; }
        else if (ti < 1408) { src = p.in[15]; dst = (u16*)(ws + WS_WO); K = 1024; N = 1024; tl_i = ti - 1152; }
        else if (ti < 2432) { src = p.in[16]; dst = (u16*)(ws + WS_W1); K = 1024; N = 4096; tl_i = ti - 1408; }
        else { src = p.in[17]; dst = (u16*)(ws + WS_W2); K = 4096; N = 1024; tl_i = ti - 2432; }
        const int nkt = K >> 6, n0 = (tl_i / nkt) * 64, k0 = (tl_i % nkt) * 64;
#pragma unroll
        for (int e = 0; e < 8; ++e) { const int idx = tid + 512 * e, kk = idx >> 6, nn = idx & 63; const int col = map ? win_src_col(n0 + nn) : n0 + nn; tl[kk * 65 + nn] = src[(size_t)(k0 + kk) * N + col]; }
        __syncthreads();
#pragma unroll
        for (int e = 0; e < 4; ++e) { const int idx = tid + 512 * e, nn = idx >> 5, kp = idx & 31; *(unsigned*)(dst + (size_t)(n0 + nn) * K + k0 + 2 * kp) = pk2(tl[(2 * kp) * 65 + nn], tl[(2 * kp + 1) * 65 + nn]); }
        __syncthreads();
    }
}

DI void norm_row(const float* src, const float* gn, const float* sh, const float* sc, u16* dst, int lane) {
    float4 v[4]; float ss = 0.f;
#pragma unroll
    for (int i = 0; i < 4; ++i) { v[i] = *(const float4*)(src + 4 * lane + 256 * i); ss += v[i].x * v[i].x + v[i].y * v[i].y + v[i].z * v[i].z + v[i].w * v[i].w; }
    ss = wave_sum(ss);
    const float rstd = __builtin_amdgcn_rsqf(ss * (1.f / 1024.f) + 1e-6f);
#pragma unroll
    for (int i = 0; i < 4; ++i) { const int c = 4 * lane + 256 * i; const float4 g = *(const float4*)(gn + c), s = *(const float4*)(sh + c), q = *(const float4*)(sc + c);
        u32x2 o; o[0] = pk2(v[i].x * rstd * g.x * (1.f + q.x) + s.x, v[i].y * rstd * g.y * (1.f + q.y) + s.y); o[1] = pk2(v[i].z * rstd * g.z * (1.f + q.z) + s.z, v[i].w * rstd * g.w * (1.f + q.w) + s.w);
        *(u32x2*)(dst + c) = o; }
}

DI bf16x8 gather8(const u16* p, size_t stride) {
    u32x4 r;
#pragma unroll
    for (int q = 0; q < 4; ++q) { const unsigned lo = p[(size_t)(2 * q) * stride], hi = p[(size_t)(2 * q + 1) * stride]; r[q] = lo | (hi << 16); }
    return __builtin_bit_cast(bf16x8, r);
}
DI void phase_fft1(const Params& p) {
    const int lane = threadIdx.x & 63, wave = threadIdx.x >> 6, l31 = lane & 31, g = lane >> 5;
    const u16* U = (const u16*)(p.ws + WS_F); u16* T1 = (u16*)(p.ws + WS_T1); const u16* F1 = (const u16*)(p.ws + WS_F1); const float2* tw = (const float2*)(p.ws + WS_TW);
    bf16x8 fa[4][4];
#pragma unroll
    for (int mt = 0; mt < 4; ++mt)
#pragma unroll
        for (int ks = 0; ks < 4; ++ks) fa[mt][ks] = *(const bf16x8*)(F1 + (32 * mt + l31) * 64 + 16 * ks + 8 * g);
    for (int t = blockIdx.x * 8 + wave; t < 8192; t += gridDim.x * 8) {
        const int b = t >> 11, n1 = (t >> 4) & 127, c0 = (t & 15) * 32;
        const u16* ub = U + ((size_t)(b * SEQ + n1)) * 512 + c0 + l31;
        bf16x8 fb[4];
#pragma unroll
        for (int ks = 0; ks < 4; ++ks) fb[ks] = gather8(ub + (size_t)(128 * (16 * ks + 8 * g)) * 512, (size_t)128 * 512);
        f32x16 acc[4];
#pragma unroll
        for (int mt = 0; mt < 4; ++mt) {
#pragma unroll
            for (int i = 0; i < 16; ++i) acc[mt][i] = 0.f;
#pragma unroll
            for (int ks = 0; ks < 4; ++ks) acc[mt] = MFMA32(fa[mt][ks], fb[ks], acc[mt]); }
#pragma unroll
        for (int mt = 0; mt < 2; ++mt)
#pragma unroll
            for (int i = 0; i < 16; ++i) { const int k2 = 32 * mt + (i >> 2) * 8 + 4 * g + (i & 3); const float2 w = tw[n1 * k2];
                const float re = acc[mt][i], im = acc[mt + 2][i];
                u16* o = T1 + ((size_t)((b * 64 + k2) * 256 + n1)) * 512 + c0 + l31;
                o[0] = f2bf(re * w.x + im * w.y); o[(size_t)128 * 512] = f2bf(im * w.x - re * w.y); }
    }
}
DI void phase_fft2(const Params& p) {
    const int lane = threadIdx.x & 63, wave = threadIdx.x >> 6, l31 = lane & 31, g = lane >> 5;
    const u16* T1 = (const u16*)(p.ws + WS_T1); u16* Z = (u16*)(p.ws + WS_Z); const u16* F2 = (const u16*)(p.ws + WS_F2);
    bf16x8 fa[16];
#pragma unroll
    for (int ks = 0; ks < 16; ++ks) fa[ks] = *(const bf16x8*)(F2 + (32 * wave + l31) * 256 + 16 * ks + 8 * g);
    for (int wt = blockIdx.x; wt < 256; wt += gridDim.x) {
        const int b = wt >> 6, k2 = wt & 63;
        for (int cch = 0; cch < 16; ++cch) {
            const u16* tb = T1 + ((size_t)(b * 64 + k2) * 256) * 512 + cch * 32 + l31;
            f32x16 acc;
#pragma unroll
            for (int i = 0; i < 16; ++i) acc[i] = 0.f;
#pragma unroll
            for (int ks = 0; ks < 16; ++ks) { const bf16x8 fb = gather8(tb + (size_t)(16 * ks + 8 * g) * 512, 512); acc = MFMA32(fa[ks], fb, acc); }
#pragma unroll
            for (int i = 0; i < 16; ++i) { const int row = 32 * wave + (i >> 2) * 8 + 4 * g + (i & 3), ri = row >> 7, k1 = row & 127;
                Z[((size_t)(b * SEQ + 64 * k1 + k2)) * 1024 + ri * 512 + cch * 32 + l31] = f2bf(acc[i] * (1.f / 1024.f)); }
        }
    }
}

DI void phase_attn(const Params& p, unsigned char* smem) {
    float* rp = (float*)smem;
    for (int i = threadIdx.x; i < 3720; i += 512) rp[128 + i] = p.in[11][i] * 1.4426950408889634f;
    __syncthreads();
    const int lane = threadIdx.x & 63, wave = threadIdx.x >> 6, n = lane & 31, g = lane >> 5;
    const u16* Qg = (const u16*)(p.ws + WS_Q); const u16* Kg = (const u16*)(p.ws + WS_K); const u16* VTg = (const u16*)(p.ws + WS_V);
    const u16* CK = (const u16*)(p.ws + WS_CTXK); const u16* CVT = (const u16*)(p.ws + WS_CTXV); u16* Y = (u16*)(p.ws + WS_YATT);
    const float SC = 0.125f * 1.4426950408889634f;
    for (int t = blockIdx.x * 8 + wave; t < 8192; t += gridDim.x * 8) {
        const int ct = t & 3, rpair = (t >> 2) & 63, bh = t >> 8, hd = bh & 7, b = bh >> 3;
        const int r0 = 2 * rpair, qrow = r0 + (n >> 4), qi = n & 15;
        const int qcol = ct == 0 ? (qi < 8 ? qi : 48 + qi) : 8 + 16 * (ct - 1) + qi;
        const int h0 = ct == 0 ? 0 : 16 * (ct - 1), h1 = ct == 0 ? 48 : 16 * ct;
        const int cs = min(max(qcol - 8, 0), 48), rs = min(max(qrow - 4, 0), 120);
        const int rs0 = min(max(r0 - 4, 0), 120), rs1 = min(max(r0 - 3, 0), 120);
        bf16x8 qf[4];
        { const u16* qp = Qg + ((size_t)bh * SEQ + qrow * 64 + qcol) * 64 + 8 * g;
#pragma unroll
          for (int ks = 0; ks < 4; ++ks) qf[ks] = *(const bf16x8*)(qp + 16 * ks); }
        unsigned cmask = 0;
#pragma unroll
        for (int i = 0; i < 16; ++i) { const int kcol = (i < 8 ? h0 : h1) + ((i >> 2) & 1) * 8 + 4 * g + (i & 3); if (kcol >= cs && kcol < cs + 16) cmask |= 1u << i; }
        const int bbase = 128 + hd * 465 + 7 * 31 + 4 * g - qcol + 15;
        const int kcolm = (n < 16 ? h0 : h1) + (n & 15);
        const u16* Kb = Kg + (size_t)bh * SEQ * 64 + (size_t)kcolm * 64 + 8 * g;
        const u16* Vb = VTg + ((size_t)bh * 64 + n) * SEQ + 8 * g;
        f32x16 O[2];
#pragma unroll
        for (int i = 0; i < 16; ++i) { O[0][i] = 0.f; O[1][i] = 0.f; }
        float lsum = 0.f;
        for (int kr = rs0; kr < rs1 + 8; ++kr) {
            const bool rowok = (kr >= rs) && (kr < rs + 8);
            bf16x8 kf[4], vf[2][2];
#pragma unroll
            for (int ks = 0; ks < 4; ++ks) kf[ks] = *(const bf16x8*)(Kb + (size_t)kr * 64 * 64 + 16 * ks);
#pragma unroll
            for (int s = 0; s < 2; ++s)
#pragma unroll
                for (int mt = 0; mt < 2; ++mt) vf[s][mt] = *(const bf16x8*)(Vb + (size_t)mt * 32 * SEQ + kr * 64 + (s ? h1 : h0));
            f32x16 S;
#pragma unroll
            for (int i = 0; i < 16; ++i) S[i] = 0.f;
#pragma unroll
            for (int ks = 0; ks < 4; ++ks) S = MFMA32(kf[ks], qf[ks], S);
            const int bidx = bbase + (kr - qrow) * 31;
            float P[16];
#pragma unroll
            for (int i = 0; i < 16; ++i) { const int off = (i < 8 ? h0 : h1) + ((i >> 2) & 1) * 8 + (i & 3);
                const float s2 = S[i] * SC + rp[bidx + off]; const float e = __builtin_amdgcn_exp2f(s2);
                const float pv = (rowok && ((cmask >> i) & 1u)) ? e : 0.f; lsum += pv; P[i] = pv; }
            const bf16x8 pb0 = __builtin_bit_cast(bf16x8, pack8(P)), pb1 = __builtin_bit_cast(bf16x8, pack8(P + 8));
#pragma unroll
            for (int mt = 0; mt < 2; ++mt) { O[mt] = MFMA32(vf[0][mt], pb0, O[mt]); O[mt] = MFMA32(vf[1][mt], pb1, O[mt]); }
        }
        const u16* CKb = CK + ((size_t)bh * CTXL + n) * 64 + 8 * g;
        const u16* CVb = CVT + ((size_t)bh * 64 + n) * CTXL + 8 * g;
        for (int kt = 0; kt < 8; ++kt) {
            bf16x8 kf[4], vf[2][2];
#pragma unroll
            for (int ks = 0; ks < 4; ++ks) kf[ks] = *(const bf16x8*)(CKb + (size_t)kt * 32 * 64 + 16 * ks);
#pragma unroll
            for (int s = 0; s < 2; ++s)
#pragma unroll
                for (int mt = 0; mt < 2; ++mt) vf[s][mt] = *(const bf16x8*)(CVb + (size_t)mt * 32 * CTXL + kt * 32 + 16 * s);
            f32x16 S;
#pragma unroll
            for (int i = 0; i < 16; ++i) S[i] = 0.f;
#pragma unroll
            for (int ks = 0; ks < 4; ++ks) S = MFMA32(kf[ks], qf[ks], S);
            float P[16];
#pragma unroll
            for (int i = 0; i < 16; ++i) { const float e = __builtin_amdgcn_exp2f(S[i] * SC); lsum += e; P[i] = e; }
            const bf16x8 pb0 = __builtin_bit_cast(bf16x8, pack8(P)), pb1 = __builtin_bit_cast(bf16x8, pack8(P + 8));
#pragma unroll
            for (int mt = 0; mt < 2; ++mt) { O[mt] = MFMA32(vf[0][mt], pb0, O[mt]); O[mt] = MFMA32(vf[1][mt], pb1, O[mt]); }
        }
        lsum += __shfl_xor(lsum, 32);
        const float inv = 1.f / lsum;
        u16* yo = Y + ((size_t)b * SEQ + qrow * 64 + qcol) * 512 + hd * 64 + 4 * g;
#pragma unroll
        for (int mt = 0; mt < 2; ++mt)
#pragma unroll
            for (int q = 0; q < 4; ++q) { u32x2 o; o[0] = pk2(O[mt][4 * q] * inv, O[mt][4 * q + 1] * inv); o[1] = pk2(O[mt][4 * q + 2] * inv, O[mt][4 * q + 3] * inv);
                *(u32x2*)(yo + 32 * mt + 8 * q) = o; }
    }
    __syncthreads();
}

__global__ __launch_bounds__(512) void mega_fwd(Params p) {
    extern __shared__ __attribute__((aligned(16))) unsigned char smem[];
    LAS unsigned char* lds = (LAS unsigned char*)smem;
    unsigned char* ws = p.ws;
    const float* ada = (const float*)(ws + WS_ADA);
    if (p.ph_lo <= 0 && 0 < p.ph_hi) {
        if (0 > p.ph_lo) { cg::this_grid().sync(); }
        if (EN(0)) phase_prep(p, smem);
    }
    asm volatile("" ::: "memory");
    if (p.ph_lo <= 1 && 1 < p.ph_hi) {
        if (1 > p.ph_lo) { cg::this_grid().sync(); }
        if (EN(1)) {
            const int lane = threadIdx.x & 63, wave = threadIdx.x >> 6;
            for (int row = blockIdx.x * 8 + wave; row < MTOK + MCTX; row += gridDim.x * 8) {
                if (row < MTOK) { const int b = row >> 13; norm_row(p.in[0] + (size_t)row * 1024, p.in[6], ada + b * 6144, ada + b * 6144 + 1024, (u16*)(ws + WS_HX) + (size_t)row * 1024, lane); }
                else { const int r = row - MTOK; norm_row(p.in[2] + (size_t)r * 1024, p.in[6], ada + 4 * 6144, ada + 4 * 6144 + 1024, (u16*)(ws + WS_HC) + (size_t)r * 1024, lane); }
            } }
    }
    asm volatile("" ::: "memory");
    if (p.ph_lo <= 2 && 2 < p.ph_hi) {
        if (2 > p.ph_lo) { cg::this_grid().sync(); }
        if (EN(2)) {
            EpiWin E; E.ws = ws; E.xl = lds + 131072;
            run_gemm2(lds, (const u16*)(ws + WS_HX), (const u16*)(ws + WS_WIN), MTOK, 2048, (const u16*)(ws + WS_HC), (const u16*)(ws + WS_WIN) + (size_t)1024 * 1024, MCTX, 1024, 1024, E);
            }
    }
    asm volatile("" ::: "memory");
    if (p.ph_lo <= 3 && 3 < p.ph_hi) {
        if (3 > p.ph_lo) { cg::this_grid().sync(); }
        if (EN(3)) phase_fft1(p);
    }
    asm volatile("" ::: "memory");
    if (p.ph_lo <= 4 && 4 < p.ph_hi) {
        if (4 > p.ph_lo) { cg::this_grid().sync(); }
        if (EN(4)) phase_fft2(p); if (EN(41)) phase_attn(p, smem);
    }
    asm volatile("" ::: "memory");
    if (p.ph_lo <= 5 && 5 < p.ph_hi) {
        if (5 > p.ph_lo) { cg::this_grid().sync(); }
        if (EN(5)) {
            EpiP5 E; E.G = (u16*)(ws + WS_GATES); E.Y = (u16*)(ws + WS_YF);
            run_gemm2(lds, (const u16*)(ws + WS_HX), (const u16*)(ws + WS_WGATE), MTOK, 2048, (const u16*)(ws + WS_Z), (const u16*)(ws + WS_WFO), MTOK, 1024, 1024, E);
            }
    }
    asm volatile("" ::: "memory");
    if (p.ph_lo <= 6 && 6 < p.ph_hi) {
        if (6 > p.ph_lo) { cg::this_grid().sync(); }
        if (EN(6)) {
            EpiMerge E; E.G = (const u16*)(ws + WS_GATES); E.YF = (const u16*)(ws + WS_YF); E.O = (u16*)(ws + WS_MERGED);
            run_gemm(lds, (const u16*)(ws + WS_YATT), (const u16*)(ws + WS_WAO), MTOK, 1024, 512, E);
            }
    }
    asm volatile("" ::: "memory");
    if (p.ph_lo <= 7 && 7 < p.ph_hi) {
        if (7 > p.ph_lo) { cg::this_grid().sync(); }
        if (EN(7)) {
            EpiResid E; E.base = p.in[0]; E.out = p.out; E.gate = ada + 2048;
            run_gemm(lds, (const u16*)(ws + WS_MERGED), (const u16*)(ws + WS_WO), MTOK, 1024, 1024, E);
            }
    }
    asm volatile("" ::: "memory");
    if (p.ph_lo <= 8 && 8 < p.ph_hi) {
        if (8 > p.ph_lo) { cg::this_grid().sync(); }
        if (EN(8)) {
            const int lane = threadIdx.x & 63, wave = threadIdx.x >> 6;
            for (int row = blockIdx.x * 8 + wave; row < MTOK; row += gridDim.x * 8) { const int b = row >> 13;
                norm_row(p.out + (size_t)row * 1024, p.in[7], ada + b * 6144 + 3072, ada + b * 6144 + 4096, (u16*)(ws + WS_HX) + (size_t)row * 1024, lane); }
            }
    }
    asm volatile("" ::: "memory");
    if (p.ph_lo <= 9 && 9 < p.ph_hi) {
        if (9 > p.ph_lo) { cg::this_grid().sync(); }
        if (EN(9)) {
            EpiBf16<1> E; E.O = (u16*)(ws + WS_A); E.ldc = 4096;
            run_gemm(lds, (const u16*)(ws + WS_HX), (const u16*)(ws + WS_W1), MTOK, 4096, 1024, E);
            }
    }
    asm volatile("" ::: "memory");
    if (p.ph_lo <= 10 && 10 < p.ph_hi) {
        if (10 > p.ph_lo) { cg::this_grid().sync(); }
        if (EN(10)) {
            EpiResid E; E.base = p.out; E.out = p.out; E.gate = ada + 5120;
            run_gemm(lds, (const u16*)(ws + WS_A), (const u16*)(ws + WS_W2), MTOK, 1024, 4096, E);
            }
    }
    asm volatile("" ::: "memory");
}

extern "C" void kernel_launch(void* const* d_in, const int* in_sizes, int n_in, void* d_out, int out_size, void* d_ws, size_t ws_size, hipStream_t stream) {
    static int grid = 0;
    if (grid == 0) {
        if (n_in != 18 || ws_size < WS_END) { fprintf(stderr, "kernel_launch: unexpected inputs (n_in %d, ws %zu)\n", n_in, ws_size); grid = -1; return; }
        int dev = 0, cus = 0, per_cu = 0;
        hipGetDevice(&dev); hipDeviceGetAttribute(&cus, hipDeviceAttributeMultiprocessorCount, dev);
        if (hipFuncSetAttribute((const void*)mega_fwd, hipFuncAttributeMaxDynamicSharedMemorySize, LDS_BYTES) != hipSuccess) { fprintf(stderr, "kernel_launch: hipFuncSetAttribute failed\n"); grid = -1; return; }
        hipOccupancyMaxActiveBlocksPerMultiprocessor(&per_cu, (const void*)mega_fwd, 512, LDS_BYTES);
        (void)hipGetLastError();
        if (per_cu < 1) per_cu = 1;
        grid = cus * 1;
        if (grid <= 0) grid = 256;
    }
    if (grid < 0) return;
    Params p{};
    for (int i = 0; i < 18; ++i) p.in[i] = (const float*)d_in[i];
    p.out = (float*)d_out; p.ws = (unsigned char*)d_ws;
#if N_LAUNCH_MODE == 0
    p.ph_lo = 0; p.ph_hi = N_PHASES;
    void* args[] = {&p};
    hipError_t e = hipLaunchCooperativeKernel((const void*)mega_fwd, dim3(grid), dim3(512), args, LDS_BYTES, stream);
    if (e != hipSuccess) fprintf(stderr, "cooperative launch failed: %s (grid %d)\n", hipGetErrorString(e), grid);
#else
    for (int ph = 0; ph < N_PHASES; ++ph) { p.ph_lo = ph; p.ph_hi = ph + 1; hipLaunchKernelGGL(mega_fwd, dim3(grid), dim3(512), LDS_BYTES, stream, p); }
#endif
}
```

```cpp
#include <hip/hip_runtime.h>
#include <hip/hip_cooperative_groups.h>
#include <cstdio>
namespace cg = cooperative_groups;
#ifndef N_LAUNCH_MODE
#define N_LAUNCH_MODE 0
#endif
namespace pg8 {
#define PG8_LAS __attribute__((address_space(3)))
typedef unsigned short bf16_t;
typedef short bf16x8 __attribute__((ext_vector_type(8)));
typedef float f32x4 __attribute__((ext_vector_type(4)));
typedef unsigned u32x4 __attribute__((ext_vector_type(4)));
constexpr int BM = 256, BK = 64, HALF = 128, HTB = HALF * BK * 2  , STAGE_BYTES = 8 * HTB, NXCD = 8, WGM = 8;

__host__ __device__ __forceinline__ int lds_byte(int r, int c) { const int st = (r >> 4) * 2 + (c >> 5), rr = r & 15, cc = c & 31, ob = rr * 64 + cc * 2; return st * 1024 + (ob ^ (((ob >> 9) & 1) << 5)); }
__host__ __device__ __forceinline__ void stage_rc(int b, int& R, int& C) { const int st = b / 1024, sb = b % 1024, swz = sb ^ (((sb >> 9) & 1) << 5); R = (st >> 1) * 16 + swz / 64; C = (st & 1) * 32 + (swz % 64) / 2; }
__host__ __device__ __forceinline__ int perm32(int rho) { const int n = rho >> 4, i = rho & 15; return 8 * (i >> 2) + 4 * n + (i & 3); }

struct Unit { int pm, pn, w; };
struct Gemm { const bf16_t* A; const bf16_t* Bt; const bf16_t* A2; const bf16_t* Bt2; int M, N, K, M2, N2, KL; };

struct DualOrder {
    int nM[2], nN[2], nwg[2], G, c;
    __host__ __device__ void init(int M, int N, int M2, int N2, int G_, int c_) { nM[0] = M / BM; nN[0] = N / BM; nwg[0] = nM[0] * nN[0]; nM[1] = M2 / BM; nN[1] = N2 / BM; nwg[1] = nM[1] * nN[1]; G = G_; c = c_; }
    static __host__ __device__ __forceinline__ void map(int wgid, int nM_, int nN_, int nwg_, Unit& u) {
        { const int q = nwg_ / NXCD, r = nwg_ % NXCD, xcd = wgid % NXCD, off = wgid / NXCD; wgid = (xcd < r ? xcd * (q + 1) : r * (q + 1) + (xcd - r) * q) + off; }
        const int nig = WGM * nN_, gid = wgid / nig, fm = gid * WGM, gsz = (nM_ - fm) < WGM ? (nM_ - fm) : WGM;
        u.pm = fm + ((wgid % nig) % gsz); u.pn = (wgid % nig) / gsz;
    }
    __host__ __device__ bool next(int i, Unit& u) const {
        long L = (long)i * G + c;
        if (L < nwg[0]) { map((int)L, nM[0], nN[0], nwg[0], u); u.w = 0;
            if (nN[0] == 8 && G == 256 && (i & 2)) u.pn = (u.pn & 4) | ((u.pn + 2) & 3);
            return true; }
        L -= nwg[0];
        if (L < nwg[1]) { map((int)L, nM[1], nN[1], nwg[1], u); u.w = 1; return true; }
        return false;
    }
    __device__ __forceinline__ void a_ready(const Unit&) const {}
    __device__ __forceinline__ void done(const Unit&) const {}
    __device__ __forceinline__ const char* aptr(const Gemm& g, const Unit& u, size_t tstep) const { return (const char*)(u.w ? g.A2 : g.A) + (size_t)u.pm * tstep; }
    __device__ __forceinline__ const char* bptr(const Gemm& g, const Unit& u, size_t tstep) const { return (const char*)(u.w ? g.Bt2 : g.Bt) + (size_t)u.pn * tstep; }
    __device__ __forceinline__ bool zero_after(const Unit&) const { return true; }
};
__device__ __forceinline__ unsigned cvt_pk_bf16(float lo, float hi) { unsigned r; asm volatile("v_cvt_pk_bf16_f32 %0, %1, %2" : "=v"(r) : "v"(lo), "v"(hi)); return r; }
template <class Epi, class Sched, bool STAMP = false>
__device__ __forceinline__ void gemm_phase(PG8_LAS unsigned char* lds, const Gemm g, const Sched& S, const Epi& E, unsigned long long* stamps) {
    const int tid = threadIdx.x, wid = __builtin_amdgcn_readfirstlane(tid >> 6), lane = tid & 63, wr = wid >> 2, wc = wid & 3, fr = lane & 15, fq = lane >> 4;
    const int K = g.K, nt = (g.KL ? g.KL : K) / BK;
    int ts_lo = 0, ts_hi = 0, nts = 0; const unsigned long long rt_entry = STAMP ? (unsigned long long)wall_clock64() : 0ull;
#define PG8_STAMP() do { if (STAMP && wid == 0 && nts < 64) { const unsigned long long _c = (unsigned long long)clock64(); \
        ts_lo = (lane == nts) ? (int)(unsigned)_c : ts_lo; ts_hi = (lane == nts) ? (int)(unsigned)(_c >> 32) : ts_hi; ++nts; } } while (0)
    PG8_STAMP();
    unsigned voffA[2], voffB[2];
#pragma unroll
    for (int i = 0; i < 2; ++i) { int R, C; stage_rc(tid * 16 + i * 8192, R, C); const int Rb = Epi::PERM ? ((R & ~31) + perm32(R & 31)) : R;
        voffA[i] = (unsigned)(R * K + C) * 2u; voffB[i] = (unsigned)(Rb * K + C) * 2u; }
    const size_t kstep = (size_t)(BK * 2);
    const size_t hstep = (size_t)HALF * K * 2;
    const size_t tstep = 2 * hstep;
    const unsigned ldsw = (unsigned)wid * 1024u;
    const int aoff = lds_byte(wr * 64 + fr, fq * 8), boff = lds_byte(wc * 32 + fr, fq * 8);
#define PG8_SA(b, h) (((b) * 2 + (h)) * HTB)
#define PG8_SB(b, h) ((4 + (b) * 2 + (h)) * HTB)
#define PG8_STAGE(bufoff, gbase, voff) do { _Pragma("unroll") for (int _i = 0; _i < 2; ++_i) \
        __builtin_amdgcn_global_load_lds((const unsigned*)((const char*)(gbase) + (voff)[_i]), (PG8_LAS unsigned*)(lds + (bufoff) + ldsw + _i * 8192), 16, 0, 0); } while (0)
#define PG8_LDA(dst, b, h) do { _Pragma("unroll") for (int m = 0; m < 4; ++m) _Pragma("unroll") for (int k = 0; k < 2; ++k) dst[m][k] = *(const PG8_LAS bf16x8*)(lds + PG8_SA(b, h) + aoff + m * 2048 + k * 1024); } while (0)
#define PG8_LDB(dst, b, h) do { _Pragma("unroll") for (int n = 0; n < 2; ++n) _Pragma("unroll") for (int k = 0; k < 2; ++k) dst[n][k] = *(const PG8_LAS bf16x8*)(lds + PG8_SB(b, h) + boff + n * 2048 + k * 1024); } while (0)
#define PG8_MMA(ai, bj, At, Bt) do { __builtin_amdgcn_s_setprio(1); _Pragma("unroll") for (int m = 0; m < 4; ++m) _Pragma("unroll") for (int n = 0; n < 2; ++n) _Pragma("unroll") for (int k = 0; k < 2; ++k) \
        acc[ai][bj][m][n] = __builtin_amdgcn_mfma_f32_16x16x32_bf16(Bt[n][k], At[m][k], acc[ai][bj][m][n], 0, 0, 0); __builtin_amdgcn_s_setprio(0); } while (0)
#define PG8_WAIT_V(n) asm volatile("s_waitcnt vmcnt(" #n ")" ::: "memory")
#define PG8_WAIT_L(n) asm volatile("s_waitcnt lgkmcnt(" #n ")" ::: "memory")
#define PG8_BAR __builtin_amdgcn_s_barrier()
#define PG8_SCHED __builtin_amdgcn_sched_barrier(0)
    Unit cur, nxt; int ui = 0;
    if (!S.next(0, cur)) return;
    f32x4 acc[2][2][4][2];
#pragma unroll
    for (int a = 0; a < 2; ++a)
#pragma unroll
        for (int b = 0; b < 2; ++b)
#pragma unroll
            for (int m = 0; m < 4; ++m)
#pragma unroll
                for (int n = 0; n < 2; ++n) acc[a][b][m][n] = (f32x4){0.f, 0.f, 0.f, 0.f};
    bf16x8 At[4][2], B0[2][2], B1[2][2];
    const char* cA = S.aptr(g, cur, tstep); const char* cB = S.bptr(g, cur, tstep);
    S.a_ready(cur);
    PG8_STAGE(PG8_SB(0, 0), cB, voffB); PG8_STAGE(PG8_SA(0, 0), cA, voffA); PG8_STAGE(PG8_SB(0, 1), cB + hstep, voffB); PG8_STAGE(PG8_SA(0, 1), cA + hstep, voffA);
    if (wr == 1) PG8_BAR;
    PG8_WAIT_V(4); PG8_BAR;
    PG8_STAGE(PG8_SB(1, 0), cB + kstep, voffB); PG8_STAGE(PG8_SA(1, 0), cA + kstep, voffA); PG8_STAGE(PG8_SB(1, 1), cB + hstep + kstep, voffB);
    PG8_WAIT_V(6); PG8_BAR;
    PG8_STAMP();
    for (;;) {
        const bool has_next = S.next(ui + 1, nxt);
        const char* nA = has_next ? S.aptr(g, nxt, tstep) : cA; const char* nB = has_next ? S.bptr(g, nxt, tstep) : cB;
        for (int t = 0; t < nt; t += 2) {
            const bool last = (t == nt - 2);
            const char* a1 = cA + (size_t)(t + 1) * kstep;
            const char* a2 = last ? nA : cA + (size_t)(t + 2) * kstep; const char* b2 = last ? nB : cB + (size_t)(t + 2) * kstep;
            const char* a3 = a2 + kstep; const char* b3 = b2 + kstep;
            if (last && has_next) S.a_ready(nxt);
            PG8_LDB(B0, 0, 0); PG8_SCHED; PG8_LDA(At, 0, 0); PG8_STAGE(PG8_SA(1, 1), a1 + hstep, voffA);
            PG8_WAIT_L(8); PG8_BAR; PG8_WAIT_L(0); PG8_MMA(0, 0, At, B0); PG8_BAR; PG8_SCHED;
            PG8_LDB(B1, 0, 1); PG8_STAGE(PG8_SB(0, 0), b2, voffB);
            PG8_BAR; PG8_WAIT_L(0); PG8_MMA(0, 1, At, B1); PG8_BAR;
            PG8_LDA(At, 0, 1); PG8_STAGE(PG8_SA(0, 0), a2, voffA);
            PG8_BAR; PG8_WAIT_L(0); PG8_MMA(1, 0, At, B0); PG8_BAR; PG8_SCHED;
            PG8_STAGE(PG8_SB(0, 1), b2 + hstep, voffB);
            PG8_WAIT_V(6); PG8_BAR; PG8_MMA(1, 1, At, B1); PG8_BAR;
            PG8_LDB(B0, 1, 0); PG8_SCHED; PG8_LDA(At, 1, 0); PG8_STAGE(PG8_SA(0, 1), a2 + hstep, voffA);
            PG8_WAIT_L(8); PG8_BAR; PG8_WAIT_L(0); PG8_MMA(0, 0, At, B0); PG8_BAR; PG8_SCHED;
            PG8_LDB(B1, 1, 1); PG8_STAGE(PG8_SB(1, 0), b3, voffB);
            PG8_BAR; PG8_WAIT_L(0); PG8_MMA(0, 1, At, B1); PG8_BAR;
            PG8_LDA(At, 1, 1); PG8_STAGE(PG8_SA(1, 0), a3, voffA);
            PG8_BAR; PG8_WAIT_L(0); PG8_MMA(1, 0, At, B0); PG8_BAR; PG8_SCHED;
            PG8_STAGE(PG8_SB(1, 1), b3 + hstep, voffB);
            PG8_WAIT_V(6); PG8_BAR; PG8_MMA(1, 1, At, B1); PG8_BAR;
        }
        PG8_STAMP();
        if constexpr (!Epi::AFTER_DRAIN) { E(acc, cur, wr, wc, fr, fq); S.done(cur); }
        PG8_STAMP();
        if (!has_next) break;
        if (S.zero_after(cur)) {
#pragma unroll
        for (int a = 0; a < 2; ++a)
#pragma unroll
            for (int b = 0; b < 2; ++b)
#pragma unroll
                for (int m = 0; m < 4; ++m)
#pragma unroll
                    for (int n = 0; n < 2; ++n) acc[a][b][m][n] = (f32x4){0.f, 0.f, 0.f, 0.f};
        }
        cur = nxt; cA = nA; cB = nB; ++ui;
    }
    PG8_WAIT_V(0);
    if (wr == 0) PG8_BAR;
    PG8_BAR;
    if constexpr (Epi::AFTER_DRAIN) { E.fused(acc, cur, wr, wc, fr, fq, lds, wid, lane); S.done(cur); }
    PG8_STAMP();
    if (STAMP && wid == 0) { stamps[lane] = lane < nts ? (((unsigned long long)(unsigned)ts_hi << 32) | (unsigned)ts_lo) : 0ull;
        if (lane == 62) stamps[62] = rt_entry; if (lane == 63) stamps[63] = (unsigned long long)wall_clock64(); }
#undef PG8_STAMP
#undef PG8_SA
#undef PG8_SB
#undef PG8_STAGE
#undef PG8_LDA
#undef PG8_LDB
#undef PG8_MMA
#undef PG8_WAIT_V
#undef PG8_WAIT_L
#undef PG8_BAR
#undef PG8_SCHED
}
}

#define LAS __attribute__((address_space(3)))
typedef unsigned short u16;
typedef short bf16x8 __attribute__((ext_vector_type(8)));
typedef float f32x4 __attribute__((ext_vector_type(4)));
typedef float f32x16 __attribute__((ext_vector_type(16)));
typedef unsigned u32x4 __attribute__((ext_vector_type(4)));
typedef unsigned u32x2 __attribute__((ext_vector_type(2)));
typedef __bf16 bf16x2_t __attribute__((ext_vector_type(2)));
typedef float f32x2_t __attribute__((ext_vector_type(2)));
#define DI __device__ __forceinline__

DI unsigned pk2(float a, float b) { f32x2_t v = {a, b}; return __builtin_bit_cast(unsigned, __builtin_convertvector(v, bf16x2_t)); }
DI u16 f2bf(float a) { return (u16)(pk2(a, 0.f) & 0xffffu); }
DI float sigm(float a) { return __builtin_amdgcn_rcpf(1.f + __builtin_amdgcn_exp2f(-1.4426950408889634f * a)); }
DI float bflo(unsigned u) { return __uint_as_float(u << 16); }
DI float bfhi(unsigned u) { return __uint_as_float(u & 0xffff0000u); }
DI u32x4 pack8(const float* v) { u32x4 r; r[0] = pk2(v[0], v[1]); r[1] = pk2(v[2], v[3]); r[2] = pk2(v[4], v[5]); r[3] = pk2(v[6], v[7]); return r; }
DI float wave_sum(float v) { v += __shfl_xor(v, 32); v += __shfl_xor(v, 16); v += __shfl_xor(v, 8); v += __shfl_xor(v, 4); v += __shfl_xor(v, 2); v += __shfl_xor(v, 1); return v; }
#define MFMA32(a, b, c) __builtin_amdgcn_mfma_f32_32x32x16_bf16((a), (b), (c), 0, 0, 0)

constexpr int NB = 4, SEQ = 8192, DM = 1024, CTXL = 256, MTOK = NB * SEQ, MCTX = NB * CTXL, DFF = 4096;
constexpr size_t MB = 1u << 20, KB = 1024;
constexpr size_t WS_WIN = 0, WS_WGATE = 4 * MB, WS_WFO = 8 * MB, WS_WAO = 42 * MB, WS_WO = 11 * MB, WS_W1 = 13 * MB, WS_W2 = 21 * MB,
    WS_ADA = 29 * MB, WS_ROPE = 29 * MB + 128 * KB, WS_TW = 29 * MB + 144 * KB, WS_F1 = 29 * MB + 208 * KB, WS_F2 = 29 * MB + 224 * KB,
    WS_QKG = 29 * MB + 352 * KB, WS_BAR = 29 * MB + 384 * KB, WS_CB = 29 * MB + 640 * KB, WS_SSP = 44 * MB, WS_RSTD = 46 * MB, WS_W1P = 320 * MB, WS_CTXK = 30 * MB, WS_F2K = 34 * MB, WS_CTXV = 31 * MB, WS_HC = 32 * MB,
    WS_F = 64 * MB, WS_Q = 96 * MB, WS_K = 128 * MB, WS_V = 160 * MB, WS_T1 = 192 * MB, WS_Z = 256 * MB,
    WS_GATES = 64 * MB, WS_YF = 192 * MB, WS_DELTA = 64 * MB, WS_A = 64 * MB, WS_HX = 320 * MB, WS_MERGED = 192 * MB, WS_YATT = 384 * MB, WS_X1B = 448 * MB, WS_END = 512 * MB;
constexpr int LDS_BYTES = 147456 + 16;
constexpr int N_PHASES = 11;
#ifndef ONLY_PH
#define ONLY_PH -1
#endif
#define EN(x) (ONLY_PH < 0 || ONLY_PH == (x))
#ifndef REPEAT_PH
#define REPEAT_PH -1
#endif
#define NREP(x) (REPEAT_PH == (x) ? 2 : 1)

namespace pg8 {
struct FusedOrder {
    int G, c; const char* ws;
    __device__ __forceinline__ bool next(int i, Unit& u) const {
        const int t = (i / 7) * G + c; if (t >= 512) return false;
        DualOrder::map(t, 128, 4, 512, u); u.w = i % 7; return true;
    }
    __device__ __forceinline__ void a_ready(const Unit&) const {}
    __device__ __forceinline__ void done(const Unit&) const {}
    __device__ __forceinline__ const char* aptr(const Gemm&, const Unit& u, size_t tstep) const {
        const int s = u.w; const size_t off = s < 4 ? WS_HX : (s < 6 ? WS_Z : WS_YATT); return ws + off + (size_t)u.pm * tstep + ((s & 1) && s < 6 ? 1024 : 0); }
    __device__ __forceinline__ const char* bptr(const Gemm&, const Unit& u, size_t tstep) const {
        const int s = u.w; const size_t off = s < 4 ? WS_WGATE : (s < 6 ? WS_WFO : WS_WAO); const int pn = (s == 2 || s == 3) ? u.pn + 4 : u.pn; return ws + off + (size_t)pn * tstep + ((s & 1) && s < 6 ? 1024 : 0); }
    __device__ __forceinline__ bool zero_after(const Unit& u) const { return u.w == 1 || u.w == 3 || u.w >= 5; }
};
}

namespace pg8 {
struct BatchBOrder : DualOrder {
    __device__ __forceinline__ const char* bptr(const Gemm& g, const Unit& u, size_t tstep) const { return (const char*)g.Bt + (size_t)(u.pm >> 5) * (8u << 20) + (size_t)u.pn * tstep; }
};
}

struct Params { const float* in[18]; float* out; unsigned char* ws; int ph_lo, ph_hi; };

DI int win_src_col(int R) {
    const int pn = R >> 8, cc = R & 255;
    if (pn < 2) return R;
    const int kind = pn >> 1, head = 4 * (pn & 1) + ((cc & 127) >> 5), bj = cc >> 7, t = cc & 31;
    int dim;
    if (kind == 3) dim = 32 * bj + t;
    else { const int fq = t >> 3, e = t & 7; dim = 32 * bj + 16 * (e >> 2) + 4 * fq + (e & 3); }
    return 512 * kind + 64 * head + dim;
}
DI int p16(int o) { return 8 * ((o >> 2) & 1) + 4 * (o >> 3) + (o & 3); }

struct EpiWin {
    static constexpr bool PERM = true, AFTER_DRAIN = false;
    unsigned char* ws; LAS unsigned char* xl;
    __device__ __forceinline__ void operator()(const f32x4 (&acc)[2][2][4][2], const pg8::Unit& u, int wr, int wc, int fr, int fq) const {
        const int ctx = u.w;
        u16* const F = (u16*)(ws + WS_F); const float2* const rope = (const float2*)(ws + WS_ROPE);
        const int kind = ctx ? 2 + (u.pn >> 1) : (u.pn >> 1);
        const int lstok = ctx ? 8 : 13, stok = 1 << lstok;
        const int rowb = u.pm * 256 + wr * 64 + fr;
        if (kind == 0) {
#pragma unroll
            for (int ai = 0; ai < 2; ++ai)
#pragma unroll
                for (int m = 0; m < 4; ++m) { const int r = rowb + ai * 128 + m * 16;
#pragma unroll
                    for (int bj = 0; bj < 2; ++bj) { const int c0 = u.pn * 256 + bj * 128 + wc * 32 + fq * 8;
                        u32x4 o; o[0] = pk2(acc[ai][bj][m][0][0], acc[ai][bj][m][0][1]); o[1] = pk2(acc[ai][bj][m][0][2], acc[ai][bj][m][0][3]);
                        o[2] = pk2(acc[ai][bj][m][1][0], acc[ai][bj][m][1][1]); o[3] = pk2(acc[ai][bj][m][1][2], acc[ai][bj][m][1][3]);
                        *(u32x4*)(F + (size_t)r * 512 + c0) = o; } }
        } else if (kind == 3) {
            const int hh = 4 * (u.pn & 1) + wc, pp = p16(fr), lane = fq * 16 + fr;
            LAS u16* vl = (LAS u16*)(xl) + (wr * 4 + wc) * 1024;
            u16* vdst = (u16*)(ws + (ctx ? WS_CTXV : WS_V));
#pragma unroll
            for (int ai = 0; ai < 2; ++ai)
#pragma unroll
                for (int m = 0; m < 4; ++m) { const int r0 = u.pm * 256 + wr * 64 + ai * 128 + m * 16, b = r0 >> lstok, t0 = r0 & (stok - 1);
#pragma unroll
                    for (int bj = 0; bj < 2; ++bj)
#pragma unroll
                        for (int e = 0; e < 8; ++e) vl[(32 * bj + 8 * fq + e) * 16 + pp] = f2bf(acc[ai][bj][m][e >> 2][e & 3]);
                    const u32x4 a0 = *(const LAS u32x4*)(vl + lane * 16), a1 = *(const LAS u32x4*)(vl + lane * 16 + 8);
                    u16* o = vdst + ((size_t)(b * 8 + hh) * 64 + lane) * stok + t0;
                    *(u32x4*)(o) = a0; *(u32x4*)(o + 8) = a1; }
        } else {
            const float* gsrc = (const float*)(ws + WS_QKG) + (kind == 1 ? 0 : 64); u16* dst = (u16*)(ws + (kind == 1 ? WS_Q : (ctx ? WS_CTXK : WS_K)));
            const int hh = 4 * (u.pn & 1) + wc;
            float gv[2][8];
#pragma unroll
            for (int bj = 0; bj < 2; ++bj)
#pragma unroll
                for (int e = 0; e < 8; ++e) gv[bj][e] = gsrc[32 * bj + 16 * (e >> 2) + 4 * fq + (e & 3)];
#pragma unroll
            for (int ai = 0; ai < 2; ++ai)
#pragma unroll
                for (int m = 0; m < 4; ++m) { __builtin_amdgcn_sched_barrier(0); const int r = rowb + ai * 128 + m * 16, b = r >> lstok, t = r & (stok - 1);
                    float v[2][8]; float ss = 0.f;
#pragma unroll
                    for (int bj = 0; bj < 2; ++bj)
#pragma unroll
                        for (int e = 0; e < 8; ++e) { v[bj][e] = acc[ai][bj][m][e >> 2][e & 3]; ss += v[bj][e] * v[bj][e]; }
                    ss += __shfl_xor(ss, 16); ss += __shfl_xor(ss, 32);
                    const float rstd = __builtin_amdgcn_rsqf(ss * (1.f / 64.f) + 1e-6f);
#pragma unroll
                    for (int bj = 0; bj < 2; ++bj)
#pragma unroll
                        for (int e = 0; e < 8; ++e) v[bj][e] *= rstd * gv[bj][e];
                    if (!ctx) {
#pragma unroll
                        for (int bj = 0; bj < 2; ++bj) { const int pos = bj == 0 ? (t >> 6) : (t & 63);
                            const float4 cs0 = *(const float4*)(rope + pos * 16 + 4 * fq), cs1 = *(const float4*)(rope + pos * 16 + 4 * fq + 2);
                            const float cc[4] = {cs0.x, cs0.z, cs1.x, cs1.z}, sn[4] = {cs0.y, cs0.w, cs1.y, cs1.w};
#pragma unroll
                            for (int e = 0; e < 4; ++e) { const float x1 = v[bj][e], x2 = v[bj][e + 4]; v[bj][e] = x1 * cc[e] - x2 * sn[e]; v[bj][e + 4] = x1 * sn[e] + x2 * cc[e]; } }
                    }
                    u16* o = dst + ((size_t)(b * 8 + hh) * stok + t) * 64 + fq * 8;
                    *(u32x4*)(o) = pack8(v[0]); *(u32x4*)(o + 32) = pack8(v[1]); }
        }
    }
};
struct EpiGates {
    static constexpr bool PERM = true, AFTER_DRAIN = false;
    u16* G;
    __device__ __forceinline__ void operator()(const f32x4 (&acc)[2][2][4][2], const pg8::Unit& u, int wr, int wc, int fr, int fq) const {
        const int rowb = u.pm * 256 + wr * 64 + fr;
#pragma unroll
        for (int ai = 0; ai < 2; ++ai)
#pragma unroll
            for (int m = 0; m < 4; ++m) { const int r = rowb + ai * 128 + m * 16;
#pragma unroll
                for (int bj = 0; bj < 2; ++bj) { __builtin_amdgcn_sched_barrier(0); const int c0 = u.pn * 256 + bj * 128 + wc * 32 + fq * 8; float v[8];
#pragma unroll
                    for (int e = 0; e < 8; ++e) v[e] = __builtin_amdgcn_rcpf(1.f + __builtin_amdgcn_exp2f(-1.4426950408889634f * acc[ai][bj][m][e >> 2][e & 3]));
                    *(u32x4*)(G + (size_t)r * 2048 + c0) = pack8(v); } }
    }
};
struct EpiP5 {
    static constexpr bool PERM = true, AFTER_DRAIN = false;
    u16* G; u16* Y;
    __device__ __forceinline__ void operator()(const f32x4 (&acc)[2][2][4][2], const pg8::Unit& u, int wr, int wc, int fr, int fq) const {
        const int rowb = u.pm * 256 + wr * 64 + fr;
        const bool sg = u.w == 0; u16* O = sg ? G : Y; const int ldc = sg ? 2048 : 1024;
#pragma unroll
        for (int ai = 0; ai < 2; ++ai)
#pragma unroll
            for (int m = 0; m < 4; ++m) { const int r = rowb + ai * 128 + m * 16;
#pragma unroll
                for (int bj = 0; bj < 2; ++bj) { const int c0 = u.pn * 256 + bj * 128 + wc * 32 + fq * 8; float v[8];
#pragma unroll
                    for (int e = 0; e < 8; ++e) { v[e] = acc[ai][bj][m][e >> 2][e & 3]; }
                    *(u32x4*)(O + (size_t)r * ldc + c0) = pack8(v); } }
    }
};
template <int ACT> struct EpiBf16 {
    static constexpr bool PERM = true, AFTER_DRAIN = false;
    u16* O; int ldc;
    __device__ __forceinline__ void operator()(const f32x4 (&acc)[2][2][4][2], const pg8::Unit& u, int wr, int wc, int fr, int fq) const {
        const int rowb = u.pm * 256 + wr * 64 + fr;
#pragma unroll
        for (int ai = 0; ai < 2; ++ai)
#pragma unroll
            for (int m = 0; m < 4; ++m) { const int r = rowb + ai * 128 + m * 16;
#pragma unroll
                for (int bj = 0; bj < 2; ++bj) { const int c0 = u.pn * 256 + bj * 128 + wc * 32 + fq * 8; float v[8];
#pragma unroll
                    for (int e = 0; e < 8; ++e) { float a = acc[ai][bj][m][e >> 2][e & 3]; if (ACT == 1) { a = fmaxf(a, 0.f); a = a * a; } v[e] = a; }
                    __builtin_nontemporal_store(pack8(v), (u32x4*)(O + (size_t)r * ldc + c0)); } }
    }
};
struct EpiMlp1 {
    static constexpr bool PERM = true, AFTER_DRAIN = false;
    u16* O; const float* SSP; const float* CB;
    __device__ __forceinline__ void operator()(const f32x4 (&acc)[2][2][4][2], const pg8::Unit& u, int wr, int wc, int fr, int fq) const {
        const int rowb = u.pm * 256 + wr * 64 + fr, b = (u.pm * 256) >> 13, cb = u.pn * 256 + wc * 32 + fq * 8;
        f32x4 cv[2][2];
#pragma unroll
        for (int bj = 0; bj < 2; ++bj)
#pragma unroll
            for (int n = 0; n < 2; ++n) cv[bj][n] = *(const f32x4*)(CB + b * 4096 + cb + bj * 128 + 4 * n);
        float rs[2][4];
#pragma unroll
        for (int ai = 0; ai < 2; ++ai)
#pragma unroll
            for (int m = 0; m < 4; ++m) rs[ai][m] = SSP[rowb + ai * 128 + m * 16];
        __builtin_amdgcn_sched_barrier(0);
#pragma unroll
        for (int ai = 0; ai < 2; ++ai)
#pragma unroll
            for (int m = 0; m < 4; ++m) { const int r = rowb + ai * 128 + m * 16;
#pragma unroll
                for (int bj = 0; bj < 2; ++bj) { float v[8];
#pragma unroll
                    for (int e = 0; e < 8; ++e) { float a = fmaxf(rs[ai][m] * acc[ai][bj][m][e >> 2][e & 3] + cv[bj][e >> 2][e & 3], 0.f); v[e] = a * a; }
                    __builtin_nontemporal_store(pack8(v), (u32x4*)(O + (size_t)r * 4096 + cb + bj * 128)); } }
    }
};
struct EpiMerge {
    static constexpr bool PERM = true, AFTER_DRAIN = false;
    const u16* G; const u16* YF; u16* O;
    __device__ __forceinline__ void operator()(const f32x4 (&acc)[2][2][4][2], const pg8::Unit& u, int wr, int wc, int fr, int fq) const {
        const int rowb = u.pm * 256 + wr * 64 + fr, cb = u.pn * 256 + wc * 32 + fq * 8;
#pragma unroll
        for (int ai = 0; ai < 2; ++ai)
#pragma unroll
            for (int mp = 0; mp < 2; ++mp) {
                u32x4 gf[2][2], ga[2][2], yf[2][2];
#pragma unroll
                for (int mm = 0; mm < 2; ++mm)
#pragma unroll
                    for (int bj = 0; bj < 2; ++bj) { const int r = rowb + ai * 128 + (2 * mp + mm) * 16, c0 = cb + bj * 128;
                        gf[mm][bj] = *(const u32x4*)(G + (size_t)r * 2048 + c0); ga[mm][bj] = *(const u32x4*)(G + (size_t)r * 2048 + 1024 + c0); yf[mm][bj] = *(const u32x4*)(YF + (size_t)r * 1024 + c0); }
                __builtin_amdgcn_sched_barrier(0);
#pragma unroll
                for (int mm = 0; mm < 2; ++mm)
#pragma unroll
                    for (int bj = 0; bj < 2; ++bj) { const int m = 2 * mp + mm, r = rowb + ai * 128 + m * 16, c0 = cb + bj * 128; float v[8];
#pragma unroll
                        for (int q = 0; q < 4; ++q) { v[2 * q] = sigm(bflo(gf[mm][bj][q])) * bflo(yf[mm][bj][q]) + sigm(bflo(ga[mm][bj][q])) * acc[ai][bj][m][q >> 1][(2 * q) & 3];
                            v[2 * q + 1] = sigm(bfhi(gf[mm][bj][q])) * bfhi(yf[mm][bj][q]) + sigm(bfhi(ga[mm][bj][q])) * acc[ai][bj][m][q >> 1][(2 * q + 1) & 3]; }
                        *(u32x4*)(O + (size_t)r * 1024 + c0) = pack8(v); }
                __builtin_amdgcn_sched_barrier(0);
            }
    }
};
struct EpiFused {
    static constexpr bool PERM = true, AFTER_DRAIN = false;
    u16* G; u16* O;
    __device__ __forceinline__ void operator()(const f32x4 (&acc)[2][2][4][2], const pg8::Unit& u, int wr, int wc, int fr, int fq) const {
        const int sub = u.w;
        if (sub == 0 || sub == 2 || sub == 4) return;
        const int rowb = u.pm * 256 + wr * 64 + fr, cb = u.pn * 256 + wc * 32 + fq * 8;
        if (sub == 1 || sub == 3) {
            u16* gp = G + (sub == 3 ? 1024 : 0);
#pragma unroll
            for (int ai = 0; ai < 2; ++ai)
#pragma unroll
                for (int m = 0; m < 4; ++m)
#pragma unroll
                    for (int bj = 0; bj < 2; ++bj) { float v[8];
#pragma unroll
                        for (int e = 0; e < 8; ++e) v[e] = acc[ai][bj][m][e >> 2][e & 3];
                        *(u32x4*)(gp + (size_t)(rowb + ai * 128 + m * 16) * 2048 + cb + bj * 128) = pack8(v); }
        } else if (sub == 5) {
#pragma unroll
            for (int ai = 0; ai < 2; ++ai) {
                u32x4 lf[4][2];
#pragma unroll
                for (int m = 0; m < 4; ++m)
#pragma unroll
                    for (int bj = 0; bj < 2; ++bj) lf[m][bj] = __builtin_nontemporal_load((const u32x4*)(G + (size_t)(rowb + ai * 128 + m * 16) * 2048 + cb + bj * 128));
                __builtin_amdgcn_sched_barrier(0);
#pragma unroll
                for (int m = 0; m < 4; ++m)
#pragma unroll
                    for (int bj = 0; bj < 2; ++bj) { float v[8];
#pragma unroll
                        for (int q = 0; q < 4; ++q) { v[2 * q] = acc[ai][bj][m][q >> 1][(2 * q) & 3] * sigm(bflo(lf[m][bj][q])); v[2 * q + 1] = acc[ai][bj][m][q >> 1][(2 * q + 1) & 3] * sigm(bfhi(lf[m][bj][q])); }
                        *(u32x4*)(G + (size_t)(rowb + ai * 128 + m * 16) * 2048 + cb + bj * 128) = pack8(v); }
                __builtin_amdgcn_sched_barrier(0);
            }
        } else {
#pragma unroll
            for (int ai = 0; ai < 2; ++ai)
#pragma unroll
                for (int mp = 0; mp < 2; ++mp) {
                    u32x4 pp[2][2], la[2][2];
#pragma unroll
                    for (int mm = 0; mm < 2; ++mm)
#pragma unroll
                        for (int bj = 0; bj < 2; ++bj) { const u16* gp = G + (size_t)(rowb + ai * 128 + (2 * mp + mm) * 16) * 2048 + cb + bj * 128; pp[mm][bj] = __builtin_nontemporal_load((const u32x4*)gp); la[mm][bj] = __builtin_nontemporal_load((const u32x4*)(gp + 1024)); }
                    __builtin_amdgcn_sched_barrier(0);
#pragma unroll
                    for (int mm = 0; mm < 2; ++mm)
#pragma unroll
                        for (int bj = 0; bj < 2; ++bj) { const int m = 2 * mp + mm; float v[8];
#pragma unroll
                            for (int q = 0; q < 4; ++q) { v[2 * q] = bflo(pp[mm][bj][q]) + acc[ai][bj][m][q >> 1][(2 * q) & 3] * sigm(bflo(la[mm][bj][q]));
                                v[2 * q + 1] = bfhi(pp[mm][bj][q]) + acc[ai][bj][m][q >> 1][(2 * q + 1) & 3] * sigm(bfhi(la[mm][bj][q])); }
                            *(u32x4*)(O + (size_t)(rowb + ai * 128 + m * 16) * 1024 + cb + bj * 128) = pack8(v); }
                    __builtin_amdgcn_sched_barrier(0);
                }
        }
    }
};
struct EpiX1 {
    static constexpr bool PERM = true, AFTER_DRAIN = false;
    u16* X; const float* gate; float* SSP;
    __device__ __forceinline__ void operator()(const f32x4 (&acc)[2][2][4][2], const pg8::Unit& u, int wr, int wc, int fr, int fq) const {
        const int rowb = u.pm * 256 + wr * 64 + fr, b = (u.pm * 256) >> 13, cb = u.pn * 256 + wc * 32 + fq * 8;
        f32x4 gt[2][2];
#pragma unroll
        for (int bj = 0; bj < 2; ++bj)
#pragma unroll
            for (int n = 0; n < 2; ++n) gt[bj][n] = *(const f32x4*)(gate + b * 6144 + cb + bj * 128 + 4 * n);
#pragma unroll
        for (int ai = 0; ai < 2; ++ai) {
            u32x4 xb[4][2];
#pragma unroll
            for (int m = 0; m < 4; ++m)
#pragma unroll
                for (int bj = 0; bj < 2; ++bj) xb[m][bj] = *(const u32x4*)(X + (size_t)(rowb + ai * 128 + m * 16) * 1024 + cb + bj * 128);
            __builtin_amdgcn_sched_barrier(0);
#pragma unroll
            for (int m = 0; m < 4; ++m) { float ssq = 0.f;
#pragma unroll
                for (int bj = 0; bj < 2; ++bj) { float v[8];
#pragma unroll
                    for (int q = 0; q < 4; ++q) { v[2 * q] = bflo(xb[m][bj][q]) + gt[bj][q >> 1][(2 * q) & 3] * acc[ai][bj][m][q >> 1][(2 * q) & 3];
                        v[2 * q + 1] = bfhi(xb[m][bj][q]) + gt[bj][q >> 1][(2 * q + 1) & 3] * acc[ai][bj][m][q >> 1][(2 * q + 1) & 3]; }
#pragma unroll
                    for (int e = 0; e < 8; ++e) ssq += v[e] * v[e];
                    *(u32x4*)(X + (size_t)(rowb + ai * 128 + m * 16) * 1024 + cb + bj * 128) = pack8(v); }
                ssq += __shfl_xor(ssq, 16); ssq += __shfl_xor(ssq, 32);
                if (fq == 0) SSP[(size_t)(rowb + ai * 128 + m * 16) * 16 + u.pn * 4 + wc] = ssq; }
            __builtin_amdgcn_sched_barrier(0);
        }
    }
};
struct EpiResid {
    static constexpr bool PERM = true, AFTER_DRAIN = false;
    const u16* base; float* out; const float* gate;
    __device__ __forceinline__ void operator()(const f32x4 (&acc)[2][2][4][2], const pg8::Unit& u, int wr, int wc, int fr, int fq) const {
        const int rowb = u.pm * 256 + wr * 64 + fr, b = (u.pm * 256) >> 13, cb = u.pn * 256 + wc * 32 + fq * 8;
        f32x4 gt[2][2];
#pragma unroll
        for (int bj = 0; bj < 2; ++bj)
#pragma unroll
            for (int n = 0; n < 2; ++n) gt[bj][n] = *(const f32x4*)(gate + b * 6144 + cb + bj * 128 + 4 * n);
        u32x4 xb[2][4][2];
#pragma unroll
        for (int ai = 0; ai < 2; ++ai)
#pragma unroll
            for (int m = 0; m < 4; ++m)
#pragma unroll
                for (int bj = 0; bj < 2; ++bj) xb[ai][m][bj] = __builtin_nontemporal_load((const u32x4*)(base + (size_t)(rowb + ai * 128 + m * 16) * 1024 + cb + bj * 128));
        __builtin_amdgcn_sched_barrier(0);
#pragma unroll
        for (int ai = 0; ai < 2; ++ai)
#pragma unroll
            for (int m = 0; m < 4; ++m)
#pragma unroll
                for (int bj = 0; bj < 2; ++bj)
#pragma unroll
                    for (int n = 0; n < 2; ++n) { f32x4 x; x[0] = bflo(xb[ai][m][bj][2 * n]); x[1] = bfhi(xb[ai][m][bj][2 * n]); x[2] = bflo(xb[ai][m][bj][2 * n + 1]); x[3] = bfhi(xb[ai][m][bj][2 * n + 1]);
                        *(f32x4*)(out + (size_t)(rowb + ai * 128 + m * 16) * 1024 + cb + bj * 128 + 4 * n) = x + gt[bj][n] * acc[ai][bj][m][n]; }
    }
};

template <class Epi> DI void run_gemm2(LAS unsigned char* lds, const u16* A, const u16* Bt, int M, int N, const u16* A2, const u16* Bt2, int M2, int N2, int K, const Epi& E) {
    pg8::Gemm g; g.A = A; g.Bt = Bt; g.M = M; g.N = N; g.K = K; g.A2 = A2; g.Bt2 = Bt2; g.M2 = M2; g.N2 = N2; g.KL = 0;
    pg8::DualOrder S; S.init(M, N, M2, N2, (int)gridDim.x, (int)blockIdx.x);
    pg8::gemm_phase<Epi, pg8::DualOrder, false>(lds, g, S, E, nullptr);
}
template <class Epi> DI void run_gemm(LAS unsigned char* lds, const u16* A, const u16* Bt, int M, int N, int K, const Epi& E) { run_gemm2(lds, A, Bt, M, N, A, Bt, 0, 0, K, E); }

DI void phase_ada(const Params& p, unsigned char* smem) {
    float* sm = (float*)smem;
    float* sl = sm; float* red = sm + 5120;
    const int tid = threadIdx.x;
    unsigned char* ws = p.ws;
    for (int i = tid; i < 5120; i += 512) { const int v = i >> 10, k = i & 1023; const float cv = v < 4 ? p.in[1][v * 1024 + k] : p.in[3][k]; sl[i] = cv / (1.f + __expf(-cv)); }
    if (blockIdx.x == 0 && tid < 128) ((float*)(ws + WS_QKG))[tid] = tid < 64 ? p.in[9][tid] * (0.125f * 1.4426950408889634f) : p.in[10][tid - 64];
    __syncthreads();
    float* ada = (float*)(ws + WS_ADA);
    for (int item = blockIdx.x; item < 256; item += gridDim.x) {
        const int q4 = tid % 6, kc = tid / 6;
        if (kc < 85) { float4 wv[13];
#pragma unroll
            for (int s = 0; s < 13; ++s) { const int k = kc + 85 * s; if (k < 1024) { const f32x4 t = __builtin_nontemporal_load((const f32x4*)(p.in[4] + (size_t)k * 6144 + item * 24 + 4 * q4)); wv[s] = make_float4(t[0], t[1], t[2], t[3]); } else wv[s] = make_float4(0.f, 0.f, 0.f, 0.f); }
            float a[5][4];
#pragma unroll
            for (int v = 0; v < 5; ++v) { a[v][0] = 0.f; a[v][1] = 0.f; a[v][2] = 0.f; a[v][3] = 0.f; }
#pragma unroll
            for (int s = 0; s < 13; ++s) { const int k = min(kc + 85 * s, 1023);
#pragma unroll
                for (int v = 0; v < 5; ++v) { const float sv = sl[v * 1024 + k]; a[v][0] += sv * wv[s].x; a[v][1] += sv * wv[s].y; a[v][2] += sv * wv[s].z; a[v][3] += sv * wv[s].w; } }
#pragma unroll
            for (int v = 0; v < 5; ++v)
#pragma unroll
                for (int c = 0; c < 4; ++c) red[(v * 85 + kc) * 24 + 4 * q4 + c] = a[v][c]; }
        __syncthreads();
        if (tid < 120) { const int v = tid / 24, j2 = tid % 24; float s = 0.f; for (int q = 0; q < 85; ++q) s += red[(v * 85 + q) * 24 + j2]; ada[v * 6144 + item * 24 + j2] = s + p.in[5][item * 24 + j2]; }
        __syncthreads();
    }
}
DI void phase_prep_rest(const Params& p, unsigned char* smem) {
    float* sm = (float*)smem; float* ctab = sm + 7680; float* tl = sm + 8192;
    const int tid = threadIdx.x; unsigned char* ws = p.ws;
    if (tid < 128) ctab[tid] = cospif((float)tid * (1.f / 64.f));
    __syncthreads();
    { float2* rope = (float2*)(ws + WS_ROPE); u16* F1 = (u16*)(ws + WS_F1); u16* F2K = (u16*)(ws + WS_F2K);
      for (int i = blockIdx.x * 512 + tid; i < 2048 + 8192; i += gridDim.x * 512) {
          if (i < 2048) { const int pos = i >> 4, jf = i & 15; const float invf = powf(10000.f, -(float)jf * (1.f / 16.f)); const float ang = (float)pos * invf; rope[i] = make_float2(cosf(ang), sinf(ang)); }
          else { const int q = i - 2048, r = q >> 6, n2 = q & 63, k2 = r & 63; const float a = (float)((k2 * n2) & 63) * (1.f / 32.f); F1[q] = f2bf(r < 64 ? cospif(a) : -sinpif(a)); }
      }
      for (int i = blockIdx.x * 512 + tid; i < 64 * 65536 / 2; i += gridDim.x * 512) {
          const int e0 = 2 * i, k2 = e0 >> 16, r = (e0 >> 8) & 255, k1 = r & 127; float v[2];
#pragma unroll
          for (int h = 0; h < 2; ++h) { const int cidx = (e0 & 255) + h, n1 = cidx & 127; const float a = (float)((n1 * (64 * k1 + k2)) & 8191) * (1.f / 4096.f);
              const bool wc = (r < 128) == (cidx < 128); float x = wc ? cospif(a) : sinpif(a); if (r >= 128 && cidx < 128) x = -x; v[h] = x; }
          *(unsigned*)(F2K + e0) = pk2(v[0], v[1]);
      } }
    { u16* dst = (u16*)(ws + WS_WFO); const float* wfo = p.in[13];
      for (int item = blockIdx.x; item < 128; item += gridDim.x) {
          const int g = item >> 5, jblk = (item >> 1) & 15, half = item & 1, j = jblk * 64 + (tid & 63), kc = half * 8 + (tid >> 6);
          float ac[8], as[8];
#pragma unroll
          for (int e = 0; e < 8; ++e) { ac[e] = 0.f; as[e] = 0.f; }
          for (int kp0 = 0; kp0 < 128; kp0 += 32) { float wv[32];
#pragma unroll
              for (int q = 0; q < 32; ++q) wv[q] = wfo[(size_t)(g * 128 + kp0 + q) * 1024 + j];
#pragma unroll
              for (int q = 0; q < 32; ++q) { const int kp = kp0 + q; const float w = wv[q];
#pragma unroll
                  for (int e = 0; e < 8; ++e) { const int idx = ((kc * 8 + e) * kp) & 127; ac[e] += ctab[idx] * w; as[e] += ctab[(idx - 32) & 127] * w; } } }
          *(u32x4*)(dst + (size_t)j * 1024 + g * 128 + kc * 8) = pack8(ac);
          *(u32x4*)(dst + (size_t)j * 1024 + 512 + g * 128 + kc * 8) = pack8(as);
      } }
    {
        auto tile_info = [&](int ti, const float*& src, u16*& dst, int& K, int& N, int& n0, int& k0, int& map, int& dp) {
            int tl_i; map = 0; dp = 0;
            if (ti < 128) { src = p.in[8]; dst = (u16*)(ws + WS_WIN); K = 1024; N = 2048; tl_i = ti; map = 1; }
            else if (ti < 256) { src = p.in[12]; dst = (u16*)(ws + WS_WGATE); K = 1024; N = 2048; tl_i = ti - 128; }
            else if (ti < 288) { src = p.in[14]; dst = (u16*)(ws + WS_WAO); K = 512; N = 1024; tl_i = ti - 256; dp = 1024; }
            else if (ti < 352) { src = p.in[15]; dst = (u16*)(ws + WS_WO); K = 1024; N = 1024; tl_i = ti - 288; }
            else if (ti < 608) { src = p.in[16]; dst = (u16*)(ws + WS_W1); K = 1024; N = 4096; tl_i = ti - 352; }
            else { src = p.in[17]; dst = (u16*)(ws + WS_W2); K = 4096; N = 1024; tl_i = ti - 608; }
            const int nkt = K >> 8; n0 = (tl_i / nkt) * 64; k0 = (tl_i % nkt) * 256; if (!dp) dp = K; };
        const int nn = tid & 63, kq = tid >> 6, n4 = tid & 15, kr = tid >> 4;
        float r[32];
#define TR_LOAD(SRC, K0, NN, N0, MAP) do { if (MAP) { const int col_ = win_src_col((N0) + nn); _Pragma("unroll") for (int e = 0; e < 32; ++e) r[e] = __builtin_nontemporal_load((SRC) + (size_t)((K0) + kq + 8 * e) * (NN) + col_); } \
            else { _Pragma("unroll") for (int e = 0; e < 8; ++e) { const f32x4 t_ = __builtin_nontemporal_load((const f32x4*)((SRC) + (size_t)((K0) + kr + 32 * e) * (NN) + (N0) + 4 * n4)); r[4 * e] = t_[0]; r[4 * e + 1] = t_[1]; r[4 * e + 2] = t_[2]; r[4 * e + 3] = t_[3]; } } } while (0)
        int ti = blockIdx.x;
        if (ti < 864) { const float* src; u16* dst; int K, N, n0, k0, map, dp; tile_info(ti, src, dst, K, N, n0, k0, map, dp); TR_LOAD(src, k0, N, n0, map); }
        for (; ti < 864; ti += gridDim.x) {
            const float* src; u16* dst; int K, N, n0, k0, map, dp; tile_info(ti, src, dst, K, N, n0, k0, map, dp);
            if (map) {
#pragma unroll
                for (int e = 0; e < 32; ++e) tl[(kq + 8 * e) * 65 + nn] = r[e];
            } else {
#pragma unroll
                for (int e = 0; e < 8; ++e) {
#pragma unroll
                    for (int c = 0; c < 4; ++c) tl[(kr + 32 * e) * 65 + 4 * n4 + c] = r[4 * e + c]; }
            }
            const int tn = ti + (int)gridDim.x;
            if (tn < 864) { const float* s2; u16* d2; int K2, N2, n2, k2, m2, dp2; tile_info(tn, s2, d2, K2, N2, n2, k2, m2, dp2); TR_LOAD(s2, k2, N2, n2, m2); }
            __syncthreads();
#pragma unroll
            for (int e = 0; e < 16; ++e) { const int idx = tid + 512 * e, n2 = idx >> 7, kp = idx & 127; *(unsigned*)(dst + (size_t)(n0 + n2) * dp + k0 + 2 * kp) = pk2(tl[(2 * kp) * 65 + n2], tl[(2 * kp + 1) * 65 + n2]); }
            __syncthreads();
        }
    }
}

template <bool BF16IN> DI void rows4(const float* const (&xs)[4], const u16* const (&ds)[4], u16* const (&os)[4], u16* const (&hs)[4], const bool (&ok)[4],
                                  const float* gn, const float* sh, const float* sc, int lane) {
    float4 v[4][4]; u32x2 d[4][4]; float4 g[4], s[4], q[4];
#pragma unroll
    for (int r = 0; r < 4; ++r) if (ok[r]) {
#pragma unroll
        for (int i = 0; i < 4; ++i) { if (BF16IN) d[r][i] = *(const u32x2*)(ds[r] + 4 * lane + 256 * i); else { const f32x4 t = __builtin_nontemporal_load((const f32x4*)(xs[r] + 4 * lane + 256 * i)); v[r][i] = make_float4(t[0], t[1], t[2], t[3]); } } }
#pragma unroll
    for (int i = 0; i < 4; ++i) { const int c = 4 * lane + 256 * i; g[i] = *(const float4*)(gn + c); s[i] = *(const float4*)(sh + c); q[i] = *(const float4*)(sc + c); }
    __builtin_amdgcn_sched_barrier(0);
#pragma unroll
    for (int r = 0; r < 4; ++r) if (ok[r]) {
        float ss = 0.f;
#pragma unroll
        for (int i = 0; i < 4; ++i) { if (BF16IN) { v[r][i].x = bflo(d[r][i][0]); v[r][i].y = bfhi(d[r][i][0]); v[r][i].z = bflo(d[r][i][1]); v[r][i].w = bfhi(d[r][i][1]); }
            ss += v[r][i].x * v[r][i].x + v[r][i].y * v[r][i].y + v[r][i].z * v[r][i].z + v[r][i].w * v[r][i].w; }
        ss = wave_sum(ss);
        const float rstd = __builtin_amdgcn_rsqf(ss * (1.f / 1024.f) + 1e-6f);
#pragma unroll
        for (int i = 0; i < 4; ++i) { const int c = 4 * lane + 256 * i;
            if (!BF16IN && os[r]) { u32x2 xo; xo[0] = pk2(v[r][i].x, v[r][i].y); xo[1] = pk2(v[r][i].z, v[r][i].w); __builtin_nontemporal_store(xo, (u32x2*)(os[r] + c)); }
            u32x2 o; o[0] = pk2(v[r][i].x * rstd * g[i].x * (1.f + q[i].x) + s[i].x, v[r][i].y * rstd * g[i].y * (1.f + q[i].y) + s[i].y);
            o[1] = pk2(v[r][i].z * rstd * g[i].z * (1.f + q[i].z) + s[i].z, v[r][i].w * rstd * g[i].w * (1.f + q[i].w) + s[i].w);
            *(u32x2*)(hs[r] + c) = o; } }
}

DI bf16x8 gather8(const u16* p, size_t stride) {
    u32x4 r;
#pragma unroll
    for (int q = 0; q < 4; ++q) { const unsigned lo = p[(size_t)(2 * q) * stride], hi = p[(size_t)(2 * q + 1) * stride]; r[q] = lo | (hi << 16); }
    return __builtin_bit_cast(bf16x8, r);
}
DI void phase_fft1(const Params& p, unsigned char* smem, int wg, int nwg) {
    const int tid = threadIdx.x, lane = tid & 63, wave = tid >> 6, l31 = lane & 31, g = lane >> 5;
    const u16* U = (const u16*)(p.ws + WS_F); u16* T1 = (u16*)(p.ws + WS_T1); const u16* F1 = (const u16*)(p.ws + WS_F1);
    u16* tile = (u16*)smem;
    bf16x8 ff[4][4];
#pragma unroll
    for (int mt = 0; mt < 4; ++mt)
#pragma unroll
        for (int ks = 0; ks < 4; ++ks) ff[mt][ks] = *(const bf16x8*)(F1 + (32 * mt + l31) * 64 + 16 * ks + 8 * g);
    const int me = l31 & 3, mg = (l31 >> 2) & 1, mq = l31 >> 3, n1i = (mq & 1) * 4 + me, cj = (mq >> 1) * 2 + mg;
    for (int wt = wg; wt < 512; wt += nwg) {
        const int b = wt >> 7, n1_0 = ((wt >> 3) & 15) * 8, c0 = (wt & 7) * 64;
        u32x4 r[8];
#pragma unroll
        for (int e = 0; e < 8; ++e) { const int q = tid + 512 * e, row = q >> 3, piece = q & 7, n2 = row >> 3, ni = row & 7;
            r[e] = __builtin_nontemporal_load((const u32x4*)(U + ((size_t)(b * SEQ + n1_0 + ni + 128 * n2)) * 512 + c0 + piece * 8)); }
#pragma unroll
        for (int e = 0; e < 8; ++e) { const int q = tid + 512 * e, row = q >> 3, piece = q & 7; u32x2 lo, hi; lo[0] = r[e][0]; lo[1] = r[e][1]; hi[0] = r[e][2]; hi[1] = r[e][3];
            *(u32x2*)(tile + row * 68 + piece * 8) = lo; *(u32x2*)(tile + row * 68 + piece * 8 + 4) = hi; }
        __syncthreads();
#pragma unroll
        for (int tt = 0; tt < 2; ++tt) {
            const int cb = (2 * wave + tt) * 4;
            bf16x8 fa[4];
#pragma unroll
            for (int ks = 0; ks < 4; ++ks) fa[ks] = gather8(tile + ((16 * ks + 8 * g) * 8 + n1i) * 68 + cb + cj, 8 * 68);
#pragma unroll
            for (int mt = 0; mt < 4; ++mt) { f32x16 acc;
#pragma unroll
                for (int i = 0; i < 16; ++i) acc[i] = 0.f;
#pragma unroll
                for (int ks = 0; ks < 4; ++ks) acc = MFMA32(fa[ks], ff[mt][ks], acc);
                const int ri = mt >> 1, k2 = 32 * (mt & 1) + l31;
                u16* o = T1 + ((((size_t)(b * 64 + k2) * 2 + ri) * 512 + c0 + cb + g) * 128 + n1_0);
                float v[16];
#pragma unroll
                for (int i = 0; i < 16; ++i) v[i] = acc[i];
                *(u32x4*)(o) = pack8(v); *(u32x4*)(o + 2 * 128) = pack8(v + 8); }
        }
        __syncthreads();
    }
}
DI void phase_fft2(const Params& p, unsigned char* smem) {
    const int tid = threadIdx.x, lane = tid & 63, wave = tid >> 6, l31 = lane & 31, g = lane >> 5;
    const u16* T1 = (const u16*)(p.ws + WS_T1); u16* Z = (u16*)(p.ws + WS_Z); const u16* F2K = (const u16*)(p.ws + WS_F2K);
    u16* buf = (u16*)smem;
    const int cperm = 16 * ((l31 >> 2) & 1) + 4 * (l31 >> 3) + (l31 & 3);
    for (int wt = blockIdx.x; wt < 256; wt += gridDim.x) {
        const int b = wt >> 6, k2 = wt & 63;
        bf16x8 ff[16];
#pragma unroll
        for (int ks = 0; ks < 16; ++ks) ff[ks] = *(const bf16x8*)(F2K + ((size_t)(k2 * 256 + 32 * wave + l31)) * 256 + 16 * ks + 8 * g);
        const u16* slab = T1 + ((size_t)(b * 64 + k2) * 2) * 512 * 128;
        u32x4 st[4];
#pragma unroll
        for (int e = 0; e < 4; ++e) { const int q = tid + 512 * e, row = q >> 4, piece = q & 15, ri = row >> 6, cl = row & 63; st[e] = *(const u32x4*)(slab + ((size_t)(ri * 512 + cl)) * 128 + piece * 8); }
#pragma unroll
        for (int e = 0; e < 4; ++e) { const int q = tid + 512 * e, row = q >> 4, piece = q & 15; *(u32x4*)(buf + row * 136 + piece * 8) = st[e]; }
        __syncthreads();
        for (int cch = 0; cch < 8; ++cch) {
            if (cch + 1 < 8) {
#pragma unroll
                for (int e = 0; e < 4; ++e) { const int q = tid + 512 * e, row = q >> 4, piece = q & 15, ri = row >> 6, cl = row & 63; st[e] = *(const u32x4*)(slab + ((size_t)(ri * 512 + (cch + 1) * 64 + cl)) * 128 + piece * 8); }
            }
            const u16* cb = buf + (cch & 1) * (128 * 136);
            f32x16 acc0, acc1;
#pragma unroll
            for (int i = 0; i < 16; ++i) { acc0[i] = 0.f; acc1[i] = 0.f; }
#pragma unroll
            for (int ks = 0; ks < 16; ++ks) { const u16* ap = cb + ((ks >> 3) * 64 + cperm) * 136 + 16 * (ks & 7) + 8 * g;
                const bf16x8 fa0 = *(const bf16x8*)ap, fa1 = *(const bf16x8*)(ap + 32 * 136); acc0 = MFMA32(fa0, ff[ks], acc0); acc1 = MFMA32(fa1, ff[ks], acc1); }
            { const int ri = wave >> 2, k1 = 32 * (wave & 3) + l31;
              u16* o = Z + ((size_t)(b * SEQ + 64 * k1 + k2)) * 1024 + ri * 512 + cch * 64 + 16 * g;
              float v[16], w[16];
#pragma unroll
              for (int i = 0; i < 16; ++i) { v[i] = acc0[i] * (1.f / 1024.f); w[i] = acc1[i] * (1.f / 1024.f); }
              *(u32x4*)(o) = pack8(v); *(u32x4*)(o + 8) = pack8(v + 8); *(u32x4*)(o + 32) = pack8(w); *(u32x4*)(o + 40) = pack8(w + 8); }
            if (cch + 1 < 8) {
                u16* nb = buf + ((cch + 1) & 1) * (128 * 136);
#pragma unroll
                for (int e = 0; e < 4; ++e) { const int q = tid + 512 * e, row = q >> 4, piece = q & 15; *(u32x4*)(nb + row * 136 + piece * 8) = st[e]; }
            }
            __syncthreads();
        }
    }
}

DI void phase_attn(const Params& p, LAS unsigned char* lds) {
    LAS float* rp = (LAS float*)lds;
    LAS u16* ckl = (LAS u16*)(lds + 16384);
    LAS u16* cvl = (LAS u16*)(lds + 16384 + 36864);
    const int tid = threadIdx.x;
    for (int i = tid; i < 4096; i += 512) { const int j = i - 128; rp[i] = (j >= 0 && j < 3720) ? p.in[11][j] * 1.4426950408889634f : 0.f; }
    const int lane = tid & 63, wave = tid >> 6, n = lane & 31, g = lane >> 5;
    const u16* Qg = (const u16*)(p.ws + WS_Q); const u16* Kg = (const u16*)(p.ws + WS_K); const u16* VTg = (const u16*)(p.ws + WS_V);
    const u16* CK = (const u16*)(p.ws + WS_CTXK); const u16* CVT = (const u16*)(p.ws + WS_CTXV); u16* Y = (u16*)(p.ws + WS_YATT);
    for (int it = blockIdx.x; it < 512; it += gridDim.x) {
        const int bh = it >> 4, band = it & 15, hd = bh & 7, b = bh >> 3;
        __syncthreads();
        {
            u32x4 rk[4], rv[4];
#pragma unroll
            for (int e = 0; e < 4; ++e) { const int q = tid + 512 * e; rk[e] = *(const u32x4*)(CK + (size_t)bh * CTXL * 64 + (size_t)q * 8); rv[e] = *(const u32x4*)(CVT + (size_t)bh * 64 * CTXL + (size_t)q * 8); }
#pragma unroll
            for (int e = 0; e < 4; ++e) { const int q = tid + 512 * e; *(LAS u32x4*)(ckl + (q >> 3) * 72 + (q & 7) * 8) = rk[e]; *(LAS u32x4*)(cvl + (q >> 5) * 264 + (q & 31) * 8) = rv[e]; }
        }
        __syncthreads();
        {
        const int ct = wave & 3, r0 = 2 * (band * 4 + (wave >> 2) * 2);
        const int qi = n & 15, qrA = r0 + (n >> 4), qrB = qrA + 2;
        const int qcol = ct == 0 ? (qi < 8 ? qi : 48 + qi) : 8 + 16 * (ct - 1) + qi;
        const int h0 = ct == 0 ? 0 : 16 * (ct - 1), h1 = ct == 0 ? 48 : 16 * ct;
        const int cs = min(max(qcol - 8, 0), 48);
        const int rsA = min(max(qrA - 4, 0), 120), rsB = min(max(qrB - 4, 0), 120);
        const int kbeg = min(max(r0 - 4, 0), 120), kend = min(max(r0 - 1, 0), 120) + 8;
        const int wA0 = kbeg, wA1 = min(max(r0 - 3, 0), 120) + 8, wB0 = min(max(r0 - 2, 0), 120), wB1 = kend;
        bf16x8 qA[4], qB[4];
        { const u16* qp = Qg + ((size_t)bh * SEQ + qrA * 64 + qcol) * 64 + 8 * g;
#pragma unroll
          for (int ks = 0; ks < 4; ++ks) { qA[ks] = *(const bf16x8*)(qp + 16 * ks); qB[ks] = *(const bf16x8*)(qp + 2 * 64 * 64 + 16 * ks); } }
        float cneg[16];
#pragma unroll
        for (int i = 0; i < 16; ++i) { const int kcol = (i < 8 ? h0 : h1) + ((i >> 2) & 1) * 8 + 4 * g + (i & 3); cneg[i] = (kcol >= cs && kcol < cs + 16) ? 0.f : -1e30f; }
        const int bbase = 128 + hd * 465 + 7 * 31 + 4 * g - qcol + 15;
        const int kcolm = (n < 16 ? h0 : h1) + (n & 15);
        const u16* Kb = Kg + (size_t)bh * SEQ * 64 + (size_t)kcolm * 64 + 8 * g;
        const u16* Vb = VTg + ((size_t)bh * 64 + n) * SEQ + 8 * g;
        f32x16 OA[2], OB[2];
#pragma unroll
        for (int i = 0; i < 16; ++i) { OA[0][i] = 0.f; OA[1][i] = 0.f; OB[0][i] = 0.f; OB[1][i] = 0.f; }
        float lA = 0.f, lB = 0.f;
#pragma unroll 1
        for (int kr = kbeg; kr < kend; ++kr) {
            bf16x8 kf[4], vf[2][2];
#pragma unroll
            for (int ks = 0; ks < 4; ++ks) kf[ks] = *(const bf16x8*)(Kb + (size_t)kr * 64 * 64 + 16 * ks);
#pragma unroll
            for (int s2 = 0; s2 < 2; ++s2)
#pragma unroll
                for (int mt = 0; mt < 2; ++mt) vf[s2][mt] = *(const bf16x8*)(Vb + (size_t)mt * 32 * SEQ + kr * 64 + (s2 ? h1 : h0));
            const int bidx = bbase + (kr - qrA) * 31;
            if (kr >= wA0 && kr < wA1) {
                const float negrow = ((kr >= rsA) && (kr < rsA + 8)) ? 0.f : -1e30f;
                f32x16 S;
#pragma unroll
                for (int i = 0; i < 16; ++i) S[i] = 0.f;
#pragma unroll
                for (int ks = 0; ks < 4; ++ks) S = MFMA32(kf[ks], qA[ks], S);
                float P[16];
#pragma unroll
                for (int i = 0; i < 16; ++i) { const int off = (i < 8 ? h0 : h1) + ((i >> 2) & 1) * 8 + (i & 3);
                    const float sv = (S[i] + rp[bidx + off]) + (cneg[i] + negrow); const float pv = __builtin_amdgcn_exp2f(sv); lA += pv; P[i] = pv; }
                const bf16x8 pb0 = __builtin_bit_cast(bf16x8, pack8(P)), pb1 = __builtin_bit_cast(bf16x8, pack8(P + 8));
#pragma unroll
                for (int mt = 0; mt < 2; ++mt) { OA[mt] = MFMA32(vf[0][mt], pb0, OA[mt]); OA[mt] = MFMA32(vf[1][mt], pb1, OA[mt]); }
            }
            if (kr >= wB0 && kr < wB1) {
                const float negrow = ((kr >= rsB) && (kr < rsB + 8)) ? 0.f : -1e30f;
                f32x16 S;
#pragma unroll
                for (int i = 0; i < 16; ++i) S[i] = 0.f;
#pragma unroll
                for (int ks = 0; ks < 4; ++ks) S = MFMA32(kf[ks], qB[ks], S);
                float P[16];
#pragma unroll
                for (int i = 0; i < 16; ++i) { const int off = (i < 8 ? h0 : h1) + ((i >> 2) & 1) * 8 + (i & 3);
                    const float sv = (S[i] + rp[bidx - 62 + off]) + (cneg[i] + negrow); const float pv = __builtin_amdgcn_exp2f(sv); lB += pv; P[i] = pv; }
                const bf16x8 pb0 = __builtin_bit_cast(bf16x8, pack8(P)), pb1 = __builtin_bit_cast(bf16x8, pack8(P + 8));
#pragma unroll
                for (int mt = 0; mt < 2; ++mt) { OB[mt] = MFMA32(vf[0][mt], pb0, OB[mt]); OB[mt] = MFMA32(vf[1][mt], pb1, OB[mt]); }
            }
        }
        bf16x8 ck[4];
#pragma unroll
        for (int ks = 0; ks < 4; ++ks) ck[ks] = *(const LAS bf16x8*)(ckl + n * 72 + 16 * ks + 8 * g);
#pragma unroll 1
        for (int kt = 0; kt < 8; ++kt) {
            bf16x8 cn[4], cv[2][2];
            { const int ktn = min(kt + 1, 7);
#pragma unroll
              for (int ks = 0; ks < 4; ++ks) cn[ks] = *(const LAS bf16x8*)(ckl + (32 * ktn + n) * 72 + 16 * ks + 8 * g); }
#pragma unroll
            for (int s2 = 0; s2 < 2; ++s2)
#pragma unroll
                for (int mt = 0; mt < 2; ++mt) cv[s2][mt] = *(const LAS bf16x8*)(cvl + (32 * mt + n) * 264 + 32 * kt + 16 * s2 + 8 * g);
            f32x16 SA, SB;
#pragma unroll
            for (int i = 0; i < 16; ++i) { SA[i] = 0.f; SB[i] = 0.f; }
#pragma unroll
            for (int ks = 0; ks < 4; ++ks) { SA = MFMA32(ck[ks], qA[ks], SA); SB = MFMA32(ck[ks], qB[ks], SB); }
            float PA[16], PB[16];
#pragma unroll
            for (int i = 0; i < 16; ++i) { const float ea = __builtin_amdgcn_exp2f(SA[i]), eb = __builtin_amdgcn_exp2f(SB[i]); lA += ea; lB += eb; PA[i] = ea; PB[i] = eb; }
            const bf16x8 a0 = __builtin_bit_cast(bf16x8, pack8(PA)), a1 = __builtin_bit_cast(bf16x8, pack8(PA + 8)), b0 = __builtin_bit_cast(bf16x8, pack8(PB)), b1 = __builtin_bit_cast(bf16x8, pack8(PB + 8));
#pragma unroll
            for (int mt = 0; mt < 2; ++mt) { OA[mt] = MFMA32(cv[0][mt], a0, OA[mt]); OB[mt] = MFMA32(cv[0][mt], b0, OB[mt]); OA[mt] = MFMA32(cv[1][mt], a1, OA[mt]); OB[mt] = MFMA32(cv[1][mt], b1, OB[mt]); }
#pragma unroll
            for (int ks = 0; ks < 4; ++ks) ck[ks] = cn[ks];
        }
        lA += __shfl_xor(lA, 32); lB += __shfl_xor(lB, 32);
        const float iA = 1.f / lA, iB = 1.f / lB;
        u16* yo = Y + ((size_t)b * SEQ + qrA * 64 + qcol) * 1024 + hd * 64 + 4 * g;
#pragma unroll
        for (int mt = 0; mt < 2; ++mt)
#pragma unroll
            for (int q = 0; q < 4; ++q) { u32x2 o; o[0] = pk2(OA[mt][4 * q] * iA, OA[mt][4 * q + 1] * iA); o[1] = pk2(OA[mt][4 * q + 2] * iA, OA[mt][4 * q + 3] * iA);
                *(u32x2*)(yo + 32 * mt + 8 * q) = o;
                u32x2 o2; o2[0] = pk2(OB[mt][4 * q] * iB, OB[mt][4 * q + 1] * iB); o2[1] = pk2(OB[mt][4 * q + 2] * iB, OB[mt][4 * q + 3] * iB);
                *(u32x2*)(yo + (size_t)2 * 64 * 1024 + 32 * mt + 8 * q) = o2; }
        }
    }
    __syncthreads();
}


#define XB_TMO      128
#define XB_XCNT(j)  (256  + 64 * (j))
#define XB_XSUB(j)  (1280 + 64 * (j))
#define XB_XGEN(j)  (2304 + 64 * (j))
#define XB_TOP      3328
#define XB_TOPGEN   3392
#define XCD_BAR_WORDS 3456
#define XB_SPIN_CAP (1u << 18)

__device__ __forceinline__ unsigned xb_ld(unsigned* p)              { return __hip_atomic_load(p, __ATOMIC_RELAXED, __HIP_MEMORY_SCOPE_AGENT); }
__device__ __forceinline__ unsigned xb_add(unsigned* p, unsigned v) { return __hip_atomic_fetch_add(p, v, __ATOMIC_RELAXED, __HIP_MEMORY_SCOPE_AGENT); }
__device__ __forceinline__ unsigned xb_xcc_id() { return (unsigned)__builtin_amdgcn_s_getreg((3 << 11) | 20) & 0xFu; }
#define XB_SPIN(cond, bar) do { unsigned _sp = 0; while (cond) { __builtin_amdgcn_s_sleep(1); \
    if ((++_sp & 255u) == 0u) { if (xb_ld(&(bar)[XB_TMO])) break; if (_sp > XB_SPIN_CAP) { atomicAdd(&(bar)[XB_TMO], 1u); break; } } } } while (0)

struct XcdBarrier {
    unsigned* bar; unsigned x;
    volatile LAS unsigned* st;
};

__device__ __forceinline__ XcdBarrier xcd_barrier_post(unsigned* bar, volatile LAS unsigned* st) {
    XcdBarrier b; b.bar = bar; b.x = xb_xcc_id(); b.st = st;
    if (threadIdx.x == 0) (void)xb_add(&bar[XB_XCNT(b.x)], 1u);
    return b;
}
__device__ __forceinline__ void xcd_barrier_complete(unsigned* bar, unsigned x, unsigned& nloc, unsigned& nx) {
    const unsigned G = gridDim.x * gridDim.y * gridDim.z;
    unsigned sum, cnt, mine, sp = 0u;
    for (;;) {
        sum = 0u; cnt = 0u; mine = 0u;
#pragma unroll
        for (unsigned j = 0; j < 16; ++j) { const unsigned c = xb_ld(&bar[XB_XCNT(j)]); sum += c; cnt += (c > 0u) ? 1u : 0u; mine = (j == x) ? c : mine; }
        if (sum == G) break;
        __builtin_amdgcn_s_sleep(1);
        if ((++sp & 255u) == 0u) { if (xb_ld(&bar[XB_TMO])) break; if (sp > XB_SPIN_CAP) { atomicAdd(&bar[XB_TMO], 1u); break; } }
    }
    nloc = mine > 0u ? mine : 1u; nx = cnt > 0u ? cnt : 1u;
}

__device__ __forceinline__ void xcd_barrier(const XcdBarrier& b) {
    asm volatile("s_waitcnt vmcnt(0)" ::: "memory");
    __syncthreads();
    if (threadIdx.x == 0) {
        unsigned* bar = b.bar;
        __builtin_amdgcn_s_waitcnt(0);
        unsigned nloc = b.st[0], nx = b.st[1];
        if (nloc == 0u) { xcd_barrier_complete(bar, b.x, nloc, nx); b.st[0] = nloc; b.st[1] = nx; }
        const unsigned old = xb_add(&bar[XB_XSUB(b.x)], 1u);
        const unsigned gen = old / nloc;
        if (old + 1u == (gen + 1u) * nloc) {
            __builtin_amdgcn_fence(__ATOMIC_RELEASE, "agent");
            asm volatile("s_waitcnt vmcnt(0)" ::: "memory");
            const unsigned og = xb_add(&bar[XB_TOP], 1u);
            const unsigned tg = og / nx;
            if (og + 1u == (tg + 1u) * nx) xb_add(&bar[XB_TOPGEN], 1u);
            else XB_SPIN(xb_ld(&bar[XB_TOPGEN]) == tg, bar);
            __builtin_amdgcn_fence(__ATOMIC_ACQUIRE, "agent");
            xb_add(&bar[XB_XGEN(b.x)], 1u);
            asm volatile("s_waitcnt vmcnt(0)" ::: "memory");
        } else {
            XB_SPIN(xb_ld(&bar[XB_XGEN(b.x)]) == gen, bar);
            __builtin_amdgcn_fence(__ATOMIC_ACQUIRE, "agent");
            asm volatile("s_waitcnt vmcnt(0)" ::: "memory");
        }
    }
    __syncthreads();
}


__global__ __launch_bounds__(512) void mega_fwd(Params p) {
    extern __shared__ __attribute__((aligned(16))) unsigned char smem[];
    LAS unsigned char* lds = (LAS unsigned char*)smem;
    unsigned char* ws = p.ws;
    const float* ada = (const float*)(ws + WS_ADA);
    volatile LAS unsigned* xst = (volatile LAS unsigned*)(lds + 147456);
    if (threadIdx.x < 4) xst[threadIdx.x] = 0u;
    __syncthreads();
    const XcdBarrier xbar = xcd_barrier_post((unsigned*)(ws + WS_BAR), xst);
    if (p.ph_hi == 12345) cg::this_grid().sync();
#define GRID_SYNC() xcd_barrier(xbar)
    if (p.ph_lo <= 0 && 0 < p.ph_hi) {
        if (0 > p.ph_lo) { GRID_SYNC(); }
        if (EN(0)) phase_ada(p, smem);
    }
    asm volatile("" ::: "memory");
    if (p.ph_lo <= 1 && 1 < p.ph_hi) {
        if (1 > p.ph_lo) { GRID_SYNC(); }
        if (EN(1)) {
            phase_prep_rest(p, smem);
            const int lane = threadIdx.x & 63, wave = threadIdx.x >> 6;
            const int nw = (int)gridDim.x * 8, w0 = (int)blockIdx.x * 8 + wave;
            for (int row = w0; row < MTOK + MCTX; row += 4 * nw) {
                const float* xs[4]; const u16* ds[4]; u16* os[4]; u16* hs[4]; bool ok[4];
#pragma unroll
                for (int q = 0; q < 4; ++q) { const int r = row + q * nw; ok[q] = r < MTOK + MCTX; ds[q] = nullptr; os[q] = r < MTOK ? (u16*)(ws + WS_X1B) + (size_t)r * 1024 : nullptr;
                    xs[q] = r < MTOK ? p.in[0] + (size_t)r * 1024 : p.in[2] + (size_t)(r - MTOK) * 1024;
                    hs[q] = r < MTOK ? (u16*)(ws + WS_HX) + (size_t)r * 1024 : (u16*)(ws + WS_HC) + (size_t)(r - MTOK) * 1024; }
                const int b = row < MTOK ? (row >> 13) : 4;
                if (nw == 2048) rows4<false>(xs, ds, os, hs, ok, p.in[6], ada + b * 6144, ada + b * 6144 + 1024, lane);
                else { for (int q = 0; q < 4; ++q) { const int r = row + q * nw; if (r < MTOK + MCTX) { const int b2 = r < MTOK ? (r >> 13) : 4; const bool o1[4] = {true, false, false, false};
                    const float* x1[4] = {xs[q], xs[q], xs[q], xs[q]}; u16* h1[4] = {hs[q], hs[q], hs[q], hs[q]}; u16* oo[4] = {os[q], os[q], os[q], os[q]}; rows4<false>(x1, ds, oo, h1, o1, p.in[6], ada + b2 * 6144, ada + b2 * 6144 + 1024, lane); } } }
            }
            }
    }
    asm volatile("" ::: "memory");
    if (p.ph_lo <= 2 && 2 < p.ph_hi) {
        if (2 > p.ph_lo) { GRID_SYNC(); }
        if (EN(2)) {
            EpiWin E; E.ws = ws; E.xl = lds + 131072;
            run_gemm2(lds, (const u16*)(ws + WS_HX), (const u16*)(ws + WS_WIN), MTOK, 2048, (const u16*)(ws + WS_HC), (const u16*)(ws + WS_WIN) + (size_t)1024 * 1024, 0, 256, 1024, E);
            }
    }
    asm volatile("" ::: "memory");
    if (p.ph_lo <= 3 && 3 < p.ph_hi) {
        if (3 > p.ph_lo) { GRID_SYNC(); }
        if (EN(3)) {
            const int nctx = gridDim.x > 32 ? 16 : 0;
            if ((int)blockIdx.x >= nctx) phase_fft1(p, smem, (int)blockIdx.x - nctx, (int)gridDim.x - nctx);
            EpiWin E; E.ws = ws; E.xl = lds + 131072;
            run_gemm2(lds, (const u16*)(ws + WS_HX), (const u16*)(ws + WS_WIN), 0, 256, (const u16*)(ws + WS_HC), (const u16*)(ws + WS_WIN) + (size_t)1024 * 1024, MCTX, 1024, 1024, E);
            }
    }
    asm volatile("" ::: "memory");
    if (p.ph_lo <= 4 && 4 < p.ph_hi) {
        if (4 > p.ph_lo) { GRID_SYNC(); }
        if (EN(4)) phase_fft2(p, smem); if (EN(41)) phase_attn(p, lds);
#if defined(PROBE_X) && PROBE_X == 41
        GRID_SYNC(); phase_attn(p, lds);
#endif
#if defined(PROBE_X) && PROBE_X == 42
        GRID_SYNC(); phase_fft2(p, smem);
#endif
    }
    asm volatile("" ::: "memory");
    if (p.ph_lo <= 5 && 5 < p.ph_hi) {
        if (5 > p.ph_lo) { GRID_SYNC(); }
        if (EN(5)) {
            EpiFused E; E.G = (u16*)(ws + WS_GATES); E.O = (u16*)(ws + WS_MERGED);
            pg8::Gemm g; g.A = (const u16*)(ws + WS_HX); g.Bt = (const u16*)(ws + WS_WGATE); g.A2 = g.A; g.Bt2 = g.Bt; g.M = MTOK; g.N = 1024; g.K = 1024; g.M2 = 0; g.N2 = 0; g.KL = 512;
            pg8::FusedOrder S; S.G = (int)gridDim.x; S.c = (int)blockIdx.x; S.ws = (const char*)ws;
            pg8::gemm_phase<EpiFused, pg8::FusedOrder, false>(lds, g, S, E, nullptr);
            }
    }
    asm volatile("" ::: "memory");
    if (p.ph_lo <= 7 && 7 < p.ph_hi) {
        if (7 > p.ph_lo) { GRID_SYNC(); }
        if (EN(7)) {
            auto prestep = [&]() {
                const u16* W1 = (const u16*)(ws + WS_W1); u16* W1P = (u16*)(ws + WS_W1P); float* CB = (float*)(ws + WS_CB);
                const int gt = (int)blockIdx.x * 512 + (int)threadIdx.x, nt = (int)gridDim.x * 512;
                for (int i = gt; i < 4096 * 128; i += nt) {
                    const int n = i >> 7, k0 = (i & 127) * 8; const u32x4 w = *(const u32x4*)(W1 + (size_t)n * 1024 + k0);
                    const float4 g0 = *(const float4*)(p.in[7] + k0), g1 = *(const float4*)(p.in[7] + k0 + 4);
#pragma unroll
                    for (int bb = 0; bb < 4; ++bb) { const float* sc = ada + bb * 6144 + 4096 + k0; const float4 s0 = *(const float4*)sc, s1 = *(const float4*)(sc + 4);
                        float v[8] = {bflo(w[0]) * g0.x * (1.f + s0.x), bfhi(w[0]) * g0.y * (1.f + s0.y), bflo(w[1]) * g0.z * (1.f + s0.z), bfhi(w[1]) * g0.w * (1.f + s0.w),
                                      bflo(w[2]) * g1.x * (1.f + s1.x), bfhi(w[2]) * g1.y * (1.f + s1.y), bflo(w[3]) * g1.z * (1.f + s1.z), bfhi(w[3]) * g1.w * (1.f + s1.w)};
                        *(u32x4*)(W1P + (size_t)bb * (4u << 20) + (size_t)n * 1024 + k0) = pack8(v); } }
                const int lane = threadIdx.x & 63, gw = (int)blockIdx.x * 8 + ((int)threadIdx.x >> 6), nw = (int)gridDim.x * 8;
                for (int o = gw; o < 4 * 4096; o += nw) { const int bb = o >> 12, n = o & 4095; float s = 0.f;
#pragma unroll
                    for (int q = 0; q < 2; ++q) { const int k0 = (lane + 64 * q) * 8; const u32x4 w = *(const u32x4*)(W1 + (size_t)n * 1024 + k0); const float* sh = ada + bb * 6144 + 3072 + k0;
                        const float4 h0 = *(const float4*)sh, h1 = *(const float4*)(sh + 4);
                        s += bflo(w[0]) * h0.x + bfhi(w[0]) * h0.y + bflo(w[1]) * h0.z + bfhi(w[1]) * h0.w + bflo(w[2]) * h1.x + bfhi(w[2]) * h1.y + bflo(w[3]) * h1.z + bfhi(w[3]) * h1.w; }
                    s = wave_sum(s); if (lane == 0) CB[o] = s; }
            };
            const bool pre_first = (((int)blockIdx.x >> 3) & 1) == 0;
            if (pre_first) prestep();
            EpiX1 E; E.X = (u16*)(ws + WS_X1B); E.gate = ada + 2048; E.SSP = (float*)(ws + WS_SSP);
            run_gemm(lds, (const u16*)(ws + WS_MERGED), (const u16*)(ws + WS_WO), MTOK, 1024, 1024, E);
            if (!pre_first) prestep();
            }
    }
    asm volatile("" ::: "memory");
    if (p.ph_lo <= 9 && 9 < p.ph_hi) {
        if (9 > p.ph_lo) { GRID_SYNC(); }
        if (EN(9)) {
            EpiMlp1 E; E.O = (u16*)(ws + WS_A); E.SSP = (const float*)(ws + WS_RSTD); E.CB = (const float*)(ws + WS_CB);
            {
                pg8::BatchBOrder S0; S0.init(MTOK, 4096, 0, 256, (int)gridDim.x, (int)blockIdx.x); pg8::Unit uu; const float* ssp = (const float*)(ws + WS_SSP); float* rst = (float*)(ws + WS_RSTD);
                for (int i = 0; S0.next(i, uu); ++i) { if (threadIdx.x < 256) { const int r = uu.pm * 256 + (int)threadIdx.x; const f32x4* sp = (const f32x4*)(ssp + (size_t)r * 16); const f32x4 s0 = sp[0], s1 = sp[1], s2 = sp[2], s3 = sp[3];
                    const float s = ((s0[0] + s0[1]) + (s0[2] + s0[3])) + ((s1[0] + s1[1]) + (s1[2] + s1[3])) + ((s2[0] + s2[1]) + (s2[2] + s2[3])) + ((s3[0] + s3[1]) + (s3[2] + s3[3]));
                    rst[r] = __builtin_amdgcn_rsqf(s * (1.f / 1024.f) + 1e-6f); } }
                __threadfence_block(); __syncthreads();
            }
            pg8::Gemm g; g.A = (const u16*)(ws + WS_X1B); g.Bt = (const u16*)(ws + WS_W1P); g.A2 = g.A; g.Bt2 = g.Bt; g.M = MTOK; g.N = 4096; g.K = 1024; g.M2 = 0; g.N2 = 256; g.KL = 0;
            pg8::BatchBOrder S; S.init(MTOK, 4096, 0, 256, (int)gridDim.x, (int)blockIdx.x);
            pg8::gemm_phase<EpiMlp1, pg8::BatchBOrder, false>(lds, g, S, E, nullptr);
            }
    }
    asm volatile("" ::: "memory");
    if (p.ph_lo <= 10 && 10 < p.ph_hi) {
        if (10 > p.ph_lo) { GRID_SYNC(); }
        if (EN(10)) {
            EpiResid E; E.base = (const u16*)(ws + WS_X1B); E.out = p.out; E.gate = ada + 5120;
#if defined(PROBE_X) && PROBE_X == 10
            { EpiBf16<0> X; X.O = (u16*)(ws + WS_HX); X.ldc = 1024; run_gemm(lds, (const u16*)(ws + WS_A), (const u16*)(ws + WS_W2), MTOK, 1024, 4096, X); } GRID_SYNC();
#endif
            run_gemm(lds, (const u16*)(ws + WS_A), (const u16*)(ws + WS_W2), MTOK, 1024, 4096, E);
            }
    }
    asm volatile("" ::: "memory");
#if defined(PROBE_X) && PROBE_X == 99
    if (p.ph_hi - p.ph_lo > 1) { for (int i = 0; i < 10; ++i) GRID_SYNC(); }
#endif
}

extern "C" void kernel_launch(void* const* d_in, const int* in_sizes, int n_in, void* d_out, int out_size, void* d_ws, size_t ws_size, hipStream_t stream) {
    static int grid = 0;
    if (grid == 0) {
        if (n_in != 18 || ws_size < WS_END) { fprintf(stderr, "kernel_launch: unexpected inputs (n_in %d, ws %zu)\n", n_in, ws_size); grid = -1; return; }
        int dev = 0, cus = 0, per_cu = 0;
        hipGetDevice(&dev); hipDeviceGetAttribute(&cus, hipDeviceAttributeMultiprocessorCount, dev);
        if (hipFuncSetAttribute((const void*)mega_fwd, hipFuncAttributeMaxDynamicSharedMemorySize, LDS_BYTES) != hipSuccess) { fprintf(stderr, "kernel_launch: hipFuncSetAttribute failed\n"); grid = -1; return; }
        hipOccupancyMaxActiveBlocksPerMultiprocessor(&per_cu, (const void*)mega_fwd, 512, LDS_BYTES);
        (void)hipGetLastError();
        if (per_cu < 1) per_cu = 1;
        grid = cus * 1;
        if (grid <= 0) grid = 256;
    }
    if (grid < 0) return;
    Params p{};
    for (int i = 0; i < 18; ++i) p.in[i] = (const float*)d_in[i];
    p.out = (float*)d_out; p.ws = (unsigned char*)d_ws;
#if N_LAUNCH_MODE == 0
    hipMemsetAsync((unsigned char*)d_ws + WS_BAR, 0, XCD_BAR_WORDS * 4, stream);
    p.ph_lo = 0; p.ph_hi = N_PHASES;
    void* args[] = {&p};
    hipError_t e = hipLaunchCooperativeKernel((const void*)mega_fwd, dim3(grid), dim3(512), args, LDS_BYTES, stream);
    if (e != hipSuccess) fprintf(stderr, "cooperative launch failed: %s (grid %d)\n", hipGetErrorString(e), grid);
#else
    for (int ph = 0; ph < N_PHASES; ++ph) { p.ph_lo = ph; p.ph_hi = ph + 1; hipLaunchKernelGGL(mega_fwd, dim3(grid), dim3(512), LDS_BYTES, stream, p); }
#endif
}
```

```cpp
#include <hip/hip_runtime.h>
#include <hip/hip_cooperative_groups.h>
#include <cstdio>
namespace cg = cooperative_groups;
#ifndef N_LAUNCH_MODE
#define N_LAUNCH_MODE 0
#endif
namespace pg8 {
#define PG8_LAS __attribute__((address_space(3)))
typedef unsigned short bf16_t;
typedef short bf16x8 __attribute__((ext_vector_type(8)));
typedef float f32x4 __attribute__((ext_vector_type(4)));
typedef unsigned u32x4 __attribute__((ext_vector_type(4)));
constexpr int BM = 256, BK = 64, HALF = 128, HTB = HALF * BK * 2  , STAGE_BYTES = 8 * HTB, NXCD = 8, WGM = 8;

__host__ __device__ __forceinline__ int lds_byte(int r, int c) { const int st = (r >> 4) * 2 + (c >> 5), rr = r & 15, cc = c & 31, ob = rr * 64 + cc * 2; return st * 1024 + (ob ^ (((ob >> 9) & 1) << 5)); }
__host__ __device__ __forceinline__ void stage_rc(int b, int& R, int& C) { const int st = b / 1024, sb = b % 1024, swz = sb ^ (((sb >> 9) & 1) << 5); R = (st >> 1) * 16 + swz / 64; C = (st & 1) * 32 + (swz % 64) / 2; }
__host__ __device__ __forceinline__ int perm32(int rho) { const int n = rho >> 4, i = rho & 15; return 8 * (i >> 2) + 4 * n + (i & 3); }

struct Unit { int pm, pn, w; };
struct Gemm { const bf16_t* A; const bf16_t* Bt; const bf16_t* A2; const bf16_t* Bt2; int M, N, K, M2, N2, KL; };

struct DualOrder {
    int nM[2], nN[2], nwg[2], G, c;
    __host__ __device__ void init(int M, int N, int M2, int N2, int G_, int c_) { nM[0] = M / BM; nN[0] = N / BM; nwg[0] = nM[0] * nN[0]; nM[1] = M2 / BM; nN[1] = N2 / BM; nwg[1] = nM[1] * nN[1]; G = G_; c = c_; }
    static __host__ __device__ __forceinline__ void map(int wgid, int nM_, int nN_, int nwg_, Unit& u) {
        { const int q = nwg_ / NXCD, r = nwg_ % NXCD, xcd = wgid % NXCD, off = wgid / NXCD; wgid = (xcd < r ? xcd * (q + 1) : r * (q + 1) + (xcd - r) * q) + off; }
        const int nig = WGM * nN_, gid = wgid / nig, fm = gid * WGM, gsz = (nM_ - fm) < WGM ? (nM_ - fm) : WGM;
        u.pm = fm + ((wgid % nig) % gsz); u.pn = (wgid % nig) / gsz;
    }
    __host__ __device__ bool next(int i, Unit& u) const {
        long L = (long)i * G + c;
        if (L < nwg[0]) { map((int)L, nM[0], nN[0], nwg[0], u); u.w = 0;
            if (nN[0] == 8 && G == 256 && (i & 2)) u.pn = (u.pn & 4) | ((u.pn + 2) & 3);
            return true; }
        L -= nwg[0];
        if (L < nwg[1]) { map((int)L, nM[1], nN[1], nwg[1], u); u.w = 1; return true; }
        return false;
    }
    __device__ __forceinline__ void a_ready(const Unit&) const {}
    __device__ __forceinline__ void done(const Unit&) const {}
    __device__ __forceinline__ const char* aptr(const Gemm& g, const Unit& u, size_t tstep) const { return (const char*)(u.w ? g.A2 : g.A) + (size_t)u.pm * tstep; }
    __device__ __forceinline__ const char* bptr(const Gemm& g, const Unit& u, size_t tstep) const { return (const char*)(u.w ? g.Bt2 : g.Bt) + (size_t)u.pn * tstep; }
    __device__ __forceinline__ bool zero_after(const Unit&) const { return true; }
};
__device__ __forceinline__ unsigned cvt_pk_bf16(float lo, float hi) { unsigned r; asm volatile("v_cvt_pk_bf16_f32 %0, %1, %2" : "=v"(r) : "v"(lo), "v"(hi)); return r; }
template <class Epi, class Sched, bool STAMP = false>
__device__ __forceinline__ void gemm_phase(PG8_LAS unsigned char* lds, const Gemm g, const Sched& S, const Epi& E, unsigned long long* stamps) {
    const int tid = threadIdx.x, wid = __builtin_amdgcn_readfirstlane(tid >> 6), lane = tid & 63, wr = wid >> 2, wc = wid & 3, fr = lane & 15, fq = lane >> 4;
    const int K = g.K, nt = (g.KL ? g.KL : K) / BK;
    int ts_lo = 0, ts_hi = 0, nts = 0; const unsigned long long rt_entry = STAMP ? (unsigned long long)wall_clock64() : 0ull;
#define PG8_STAMP() do { if (STAMP && wid == 0 && nts < 64) { const unsigned long long _c = (unsigned long long)clock64(); \
        ts_lo = (lane == nts) ? (int)(unsigned)_c : ts_lo; ts_hi = (lane == nts) ? (int)(unsigned)(_c >> 32) : ts_hi; ++nts; } } while (0)
    PG8_STAMP();
    unsigned voffA[2], voffB[2];
#pragma unroll
    for (int i = 0; i < 2; ++i) { int R, C; stage_rc(tid * 16 + i * 8192, R, C); const int Rb = Epi::PERM ? ((R & ~31) + perm32(R & 31)) : R;
        voffA[i] = (unsigned)(R * K + C) * 2u; voffB[i] = (unsigned)(Rb * K + C) * 2u; }
    const size_t kstep = (size_t)(BK * 2);
    const size_t hstep = (size_t)HALF * K * 2;
    const size_t tstep = 2 * hstep;
    const unsigned ldsw = (unsigned)wid * 1024u;
    const int aoff = lds_byte(wr * 64 + fr, fq * 8), boff = lds_byte(wc * 32 + fr, fq * 8);
#define PG8_SA(b, h) (((b) * 2 + (h)) * HTB)
#define PG8_SB(b, h) ((4 + (b) * 2 + (h)) * HTB)
#define PG8_STAGE(bufoff, gbase, voff) do { _Pragma("unroll") for (int _i = 0; _i < 2; ++_i) \
        __builtin_amdgcn_global_load_lds((const unsigned*)((const char*)(gbase) + (voff)[_i]), (PG8_LAS unsigned*)(lds + (bufoff) + ldsw + _i * 8192), 16, 0, 0); } while (0)
#define PG8_LDA(dst, b, h) do { _Pragma("unroll") for (int m = 0; m < 4; ++m) _Pragma("unroll") for (int k = 0; k < 2; ++k) dst[m][k] = *(const PG8_LAS bf16x8*)(lds + PG8_SA(b, h) + aoff + m * 2048 + k * 1024); } while (0)
#define PG8_LDB(dst, b, h) do { _Pragma("unroll") for (int n = 0; n < 2; ++n) _Pragma("unroll") for (int k = 0; k < 2; ++k) dst[n][k] = *(const PG8_LAS bf16x8*)(lds + PG8_SB(b, h) + boff + n * 2048 + k * 1024); } while (0)
#define PG8_MMA(ai, bj, At, Bt) do { __builtin_amdgcn_s_setprio(1); _Pragma("unroll") for (int m = 0; m < 4; ++m) _Pragma("unroll") for (int n = 0; n < 2; ++n) _Pragma("unroll") for (int k = 0; k < 2; ++k) \
        acc[ai][bj][m][n] = __builtin_amdgcn_mfma_f32_16x16x32_bf16(Bt[n][k], At[m][k], acc[ai][bj][m][n], 0, 0, 0); __builtin_amdgcn_s_setprio(0); } while (0)
#define PG8_WAIT_V(n) asm volatile("s_waitcnt vmcnt(" #n ")" ::: "memory")
#define PG8_WAIT_L(n) asm volatile("s_waitcnt lgkmcnt(" #n ")" ::: "memory")
#define PG8_BAR __builtin_amdgcn_s_barrier()
#define PG8_SCHED __builtin_amdgcn_sched_barrier(0)
    Unit cur, nxt; int ui = 0;
    if (!S.next(0, cur)) return;
    f32x4 acc[2][2][4][2];
#pragma unroll
    for (int a = 0; a < 2; ++a)
#pragma unroll
        for (int b = 0; b < 2; ++b)
#pragma unroll
            for (int m = 0; m < 4; ++m)
#pragma unroll
                for (int n = 0; n < 2; ++n) acc[a][b][m][n] = (f32x4){0.f, 0.f, 0.f, 0.f};
    bf16x8 At[4][2], B0[2][2], B1[2][2];
    const char* cA = S.aptr(g, cur, tstep); const char* cB = S.bptr(g, cur, tstep);
    S.a_ready(cur);
    PG8_STAGE(PG8_SB(0, 0), cB, voffB); PG8_STAGE(PG8_SA(0, 0), cA, voffA); PG8_STAGE(PG8_SB(0, 1), cB + hstep, voffB); PG8_STAGE(PG8_SA(0, 1), cA + hstep, voffA);
    if (wr == 1) PG8_BAR;
    PG8_WAIT_V(4); PG8_BAR;
    PG8_STAGE(PG8_SB(1, 0), cB + kstep, voffB); PG8_STAGE(PG8_SA(1, 0), cA + kstep, voffA); PG8_STAGE(PG8_SB(1, 1), cB + hstep + kstep, voffB);
    PG8_WAIT_V(6); PG8_BAR;
    PG8_STAMP();
    for (;;) {
        const bool has_next = S.next(ui + 1, nxt);
        const char* nA = has_next ? S.aptr(g, nxt, tstep) : cA; const char* nB = has_next ? S.bptr(g, nxt, tstep) : cB;
        for (int t = 0; t < nt; t += 2) {
            const bool last = (t == nt - 2);
            const char* a1 = cA + (size_t)(t + 1) * kstep;
            const char* a2 = last ? nA : cA + (size_t)(t + 2) * kstep; const char* b2 = last ? nB : cB + (size_t)(t + 2) * kstep;
            const char* a3 = a2 + kstep; const char* b3 = b2 + kstep;
            if (last && has_next) S.a_ready(nxt);
            PG8_LDB(B0, 0, 0); PG8_SCHED; PG8_LDA(At, 0, 0); PG8_STAGE(PG8_SA(1, 1), a1 + hstep, voffA);
            PG8_WAIT_L(8); PG8_BAR; PG8_WAIT_L(0); PG8_MMA(0, 0, At, B0); PG8_BAR; PG8_SCHED;
            PG8_LDB(B1, 0, 1); PG8_STAGE(PG8_SB(0, 0), b2, voffB);
            PG8_BAR; PG8_WAIT_L(0); PG8_MMA(0, 1, At, B1); PG8_BAR;
            PG8_LDA(At, 0, 1); PG8_STAGE(PG8_SA(0, 0), a2, voffA);
            PG8_BAR; PG8_WAIT_L(0); PG8_MMA(1, 0, At, B0); PG8_BAR; PG8_SCHED;
            PG8_STAGE(PG8_SB(0, 1), b2 + hstep, voffB);
            PG8_WAIT_V(6); PG8_BAR; PG8_MMA(1, 1, At, B1); PG8_BAR;
            PG8_LDB(B0, 1, 0); PG8_SCHED; PG8_LDA(At, 1, 0); PG8_STAGE(PG8_SA(0, 1), a2 + hstep, voffA);
            PG8_WAIT_L(8); PG8_BAR; PG8_WAIT_L(0); PG8_MMA(0, 0, At, B0); PG8_BAR; PG8_SCHED;
            PG8_LDB(B1, 1, 1); PG8_STAGE(PG8_SB(1, 0), b3, voffB);
            PG8_BAR; PG8_WAIT_L(0); PG8_MMA(0, 1, At, B1); PG8_BAR;
            PG8_LDA(At, 1, 1); PG8_STAGE(PG8_SA(1, 0), a3, voffA);
            PG8_BAR; PG8_WAIT_L(0); PG8_MMA(1, 0, At, B0); PG8_BAR; PG8_SCHED;
            PG8_STAGE(PG8_SB(1, 1), b3 + hstep, voffB);
            PG8_WAIT_V(6); PG8_BAR; PG8_MMA(1, 1, At, B1); PG8_BAR;
        }
        PG8_STAMP();
        if constexpr (!Epi::AFTER_DRAIN) { E(acc, cur, wr, wc, fr, fq); S.done(cur); }
        PG8_STAMP();
        if (!has_next) break;
        if (S.zero_after(cur)) {
#pragma unroll
        for (int a = 0; a < 2; ++a)
#pragma unroll
            for (int b = 0; b < 2; ++b)
#pragma unroll
                for (int m = 0; m < 4; ++m)
#pragma unroll
                    for (int n = 0; n < 2; ++n) acc[a][b][m][n] = (f32x4){0.f, 0.f, 0.f, 0.f};
        }
        cur = nxt; cA = nA; cB = nB; ++ui;
    }
    PG8_WAIT_V(0);
    if (wr == 0) PG8_BAR;
    PG8_BAR;
    if constexpr (Epi::AFTER_DRAIN) { E.fused(acc, cur, wr, wc, fr, fq, lds, wid, lane); S.done(cur); }
    PG8_STAMP();
    if (STAMP && wid == 0) { stamps[lane] = lane < nts ? (((unsigned long long)(unsigned)ts_hi << 32) | (unsigned)ts_lo) : 0ull;
        if (lane == 62) stamps[62] = rt_entry; if (lane == 63) stamps[63] = (unsigned long long)wall_clock64(); }
#undef PG8_STAMP
#undef PG8_SA
#undef PG8_SB
#undef PG8_STAGE
#undef PG8_LDA
#undef PG8_LDB
#undef PG8_MMA
#undef PG8_WAIT_V
#undef PG8_WAIT_L
#undef PG8_BAR
#undef PG8_SCHED
}
}

#define LAS __attribute__((address_space(3)))
typedef unsigned short u16;
typedef short bf16x8 __attribute__((ext_vector_type(8)));
typedef float f32x4 __attribute__((ext_vector_type(4)));
typedef float f32x16 __attribute__((ext_vector_type(16)));
typedef unsigned u32x4 __attribute__((ext_vector_type(4)));
typedef unsigned u32x2 __attribute__((ext_vector_type(2)));
typedef __bf16 bf16x2_t __attribute__((ext_vector_type(2)));
typedef float f32x2_t __attribute__((ext_vector_type(2)));
#define DI __device__ __forceinline__

DI unsigned pk2(float a, float b) { f32x2_t v = {a, b}; return __builtin_bit_cast(unsigned, __builtin_convertvector(v, bf16x2_t)); }
DI u16 f2bf(float a) { return (u16)(pk2(a, 0.f) & 0xffffu); }
DI float sigm(float a) { return __builtin_amdgcn_rcpf(1.f + __builtin_amdgcn_exp2f(-1.4426950408889634f * a)); }
DI float bflo(unsigned u) { return __uint_as_float(u << 16); }
DI float bfhi(unsigned u) { return __uint_as_float(u & 0xffff0000u); }
DI u32x4 pack8(const float* v) { u32x4 r; r[0] = pk2(v[0], v[1]); r[1] = pk2(v[2], v[3]); r[2] = pk2(v[4], v[5]); r[3] = pk2(v[6], v[7]); return r; }
DI float wave_sum(float v) { v += __shfl_xor(v, 32); v += __shfl_xor(v, 16); v += __shfl_xor(v, 8); v += __shfl_xor(v, 4); v += __shfl_xor(v, 2); v += __shfl_xor(v, 1); return v; }
#define MFMA32(a, b, c) __builtin_amdgcn_mfma_f32_32x32x16_bf16((a), (b), (c), 0, 0, 0)

constexpr int NB = 4, SEQ = 8192, DM = 1024, CTXL = 256, MTOK = NB * SEQ, MCTX = NB * CTXL, DFF = 4096;
constexpr size_t MB = 1u << 20, KB = 1024;
constexpr size_t WS_WIN = 0, WS_WGATE = 4 * MB, WS_WFO = 8 * MB, WS_WAO = 42 * MB, WS_WO = 11 * MB, WS_W1 = 13 * MB, WS_W2 = 21 * MB,
    WS_ADA = 29 * MB, WS_ROPE = 29 * MB + 128 * KB, WS_TW = 29 * MB + 144 * KB, WS_F1 = 29 * MB + 208 * KB, WS_F2 = 29 * MB + 224 * KB,
    WS_QKG = 29 * MB + 352 * KB, WS_BAR = 29 * MB + 384 * KB, WS_CB = 29 * MB + 640 * KB, WS_SSP = 44 * MB, WS_RSTD = 46 * MB, WS_W1P = 320 * MB, WS_CTXK = 30 * MB, WS_F2K = 34 * MB, WS_CTXV = 31 * MB, WS_HC = 32 * MB,
    WS_F = 64 * MB, WS_Q = 96 * MB, WS_K = 128 * MB, WS_V = 160 * MB, WS_T1 = 192 * MB, WS_Z = 256 * MB,
    WS_GATES = 64 * MB, WS_YF = 192 * MB, WS_DELTA = 64 * MB, WS_A = 64 * MB, WS_HX = 320 * MB, WS_MERGED = 192 * MB, WS_YATT = 384 * MB, WS_X1B = 448 * MB, WS_END = 512 * MB;
constexpr int LDS_BYTES = 147456 + 16;
constexpr int N_PHASES = 11;
#ifndef ONLY_PH
#define ONLY_PH -1
#endif
#define EN(x) (ONLY_PH < 0 || ONLY_PH == (x))
#ifndef REPEAT_PH
#define REPEAT_PH -1
#endif
#define NREP(x) (REPEAT_PH == (x) ? 2 : 1)

namespace pg8 {
struct FusedOrder {
    int G, c; const char* ws;
    __device__ __forceinline__ bool next(int i, Unit& u) const {
        const int t = (i / 7) * G + c; if (t >= 512) return false;
        DualOrder::map(t, 128, 4, 512, u); u.w = i % 7; return true;
    }
    __device__ __forceinline__ void a_ready(const Unit&) const {}
    __device__ __forceinline__ void done(const Unit&) const {}
    __device__ __forceinline__ const char* aptr(const Gemm&, const Unit& u, size_t tstep) const {
        const int s = u.w; const size_t off = s < 4 ? WS_HX : (s < 6 ? WS_Z : WS_YATT); return ws + off + (size_t)u.pm * tstep + ((s & 1) && s < 6 ? 1024 : 0); }
    __device__ __forceinline__ const char* bptr(const Gemm&, const Unit& u, size_t tstep) const {
        const int s = u.w; const size_t off = s < 4 ? WS_WGATE : (s < 6 ? WS_WFO : WS_WAO); const int pn = (s == 2 || s == 3) ? u.pn + 4 : u.pn; return ws + off + (size_t)pn * tstep + ((s & 1) && s < 6 ? 1024 : 0); }
    __device__ __forceinline__ bool zero_after(const Unit& u) const { return u.w == 1 || u.w == 3 || u.w >= 5; }
};
}

namespace pg8 {
struct BatchBOrder : DualOrder {
    __device__ __forceinline__ const char* bptr(const Gemm& g, const Unit& u, size_t tstep) const { return (const char*)g.Bt + (size_t)(u.pm >> 5) * (8u << 20) + (size_t)u.pn * tstep; }
};
}

struct Params { const float* in[18]; float* out; unsigned char* ws; int ph_lo, ph_hi; };

DI int win_src_col(int R) {
    const int pn = R >> 8, cc = R & 255;
    if (pn < 2) return R;
    const int kind = pn >> 1, head = 4 * (pn & 1) + ((cc & 127) >> 5), bj = cc >> 7, t = cc & 31;
    int dim;
    if (kind == 3) dim = 32 * bj + t;
    else { const int fq = t >> 3, e = t & 7; dim = 32 * bj + 16 * (e >> 2) + 4 * fq + (e & 3); }
    return 512 * kind + 64 * head + dim;
}
DI int p16(int o) { return 8 * ((o >> 2) & 1) + 4 * (o >> 3) + (o & 3); }

struct EpiWin {
    static constexpr bool PERM = true, AFTER_DRAIN = false;
    unsigned char* ws; LAS unsigned char* xl;
    __device__ __forceinline__ void operator()(const f32x4 (&acc)[2][2][4][2], const pg8::Unit& u, int wr, int wc, int fr, int fq) const {
        const int ctx = u.w;
        u16* const F = (u16*)(ws + WS_F); const float2* const rope = (const float2*)(ws + WS_ROPE);
        const int kind = ctx ? 2 + (u.pn >> 1) : (u.pn >> 1);
        const int lstok = ctx ? 8 : 13, stok = 1 << lstok;
        const int rowb = u.pm * 256 + wr * 64 + fr;
        if (kind == 0) {
#pragma unroll
            for (int ai = 0; ai < 2; ++ai)
#pragma unroll
                for (int m = 0; m < 4; ++m) { const int r = rowb + ai * 128 + m * 16;
#pragma unroll
                    for (int bj = 0; bj < 2; ++bj) { const int c0 = u.pn * 256 + bj * 128 + wc * 32 + fq * 8;
                        u32x4 o; o[0] = pk2(acc[ai][bj][m][0][0], acc[ai][bj][m][0][1]); o[1] = pk2(acc[ai][bj][m][0][2], acc[ai][bj][m][0][3]);
                        o[2] = pk2(acc[ai][bj][m][1][0], acc[ai][bj][m][1][1]); o[3] = pk2(acc[ai][bj][m][1][2], acc[ai][bj][m][1][3]);
                        *(u32x4*)(F + (size_t)r * 512 + c0) = o; } }
        } else if (kind == 3) {
            const int hh = 4 * (u.pn & 1) + wc, pp = p16(fr), lane = fq * 16 + fr;
            LAS u16* vl = (LAS u16*)(xl) + (wr * 4 + wc) * 1024;
            u16* vdst = (u16*)(ws + (ctx ? WS_CTXV : WS_V));
#pragma unroll
            for (int ai = 0; ai < 2; ++ai)
#pragma unroll
                for (int m = 0; m < 4; ++m) { const int r0 = u.pm * 256 + wr * 64 + ai * 128 + m * 16, b = r0 >> lstok, t0 = r0 & (stok - 1);
#pragma unroll
                    for (int bj = 0; bj < 2; ++bj)
#pragma unroll
                        for (int e = 0; e < 8; ++e) vl[(32 * bj + 8 * fq + e) * 16 + pp] = f2bf(acc[ai][bj][m][e >> 2][e & 3]);
                    const u32x4 a0 = *(const LAS u32x4*)(vl + lane * 16), a1 = *(const LAS u32x4*)(vl + lane * 16 + 8);
                    u16* o = vdst + ((size_t)(b * 8 + hh) * 64 + lane) * stok + t0;
                    *(u32x4*)(o) = a0; *(u32x4*)(o + 8) = a1; }
        } else {
            const float* gsrc = (const float*)(ws + WS_QKG) + (kind == 1 ? 0 : 64); u16* dst = (u16*)(ws + (kind == 1 ? WS_Q : (ctx ? WS_CTXK : WS_K)));
            const int hh = 4 * (u.pn & 1) + wc;
            float gv[2][8];
#pragma unroll
            for (int bj = 0; bj < 2; ++bj)
#pragma unroll
                for (int e = 0; e < 8; ++e) gv[bj][e] = gsrc[32 * bj + 16 * (e >> 2) + 4 * fq + (e & 3)];
#pragma unroll
            for (int ai = 0; ai < 2; ++ai)
#pragma unroll
                for (int m = 0; m < 4; ++m) { __builtin_amdgcn_sched_barrier(0); const int r = rowb + ai * 128 + m * 16, b = r >> lstok, t = r & (stok - 1);
                    float v[2][8]; float ss = 0.f;
#pragma unroll
                    for (int bj = 0; bj < 2; ++bj)
#pragma unroll
                        for (int e = 0; e < 8; ++e) { v[bj][e] = acc[ai][bj][m][e >> 2][e & 3]; ss += v[bj][e] * v[bj][e]; }
                    ss += __shfl_xor(ss, 16); ss += __shfl_xor(ss, 32);
                    const float rstd = __builtin_amdgcn_rsqf(ss * (1.f / 64.f) + 1e-6f);
#pragma unroll
                    for (int bj = 0; bj < 2; ++bj)
#pragma unroll
                        for (int e = 0; e < 8; ++e) v[bj][e] *= rstd * gv[bj][e];
                    if (!ctx) {
#pragma unroll
                        for (int bj = 0; bj < 2; ++bj) { const int pos = bj == 0 ? (t >> 6) : (t & 63);
                            const float4 cs0 = *(const float4*)(rope + pos * 16 + 4 * fq), cs1 = *(const float4*)(rope + pos * 16 + 4 * fq + 2);
                            const float cc[4] = {cs0.x, cs0.z, cs1.x, cs1.z}, sn[4] = {cs0.y, cs0.w, cs1.y, cs1.w};
#pragma unroll
                            for (int e = 0; e < 4; ++e) { const float x1 = v[bj][e], x2 = v[bj][e + 4]; v[bj][e] = x1 * cc[e] - x2 * sn[e]; v[bj][e + 4] = x1 * sn[e] + x2 * cc[e]; } }
                    }
                    u16* o = dst + ((size_t)(b * 8 + hh) * stok + t) * 64 + fq * 8;
                    *(u32x4*)(o) = pack8(v[0]); *(u32x4*)(o + 32) = pack8(v[1]); }
        }
    }
};
struct EpiGates {
    static constexpr bool PERM = true, AFTER_DRAIN = false;
    u16* G;
    __device__ __forceinline__ void operator()(const f32x4 (&acc)[2][2][4][2], const pg8::Unit& u, int wr, int wc, int fr, int fq) const {
        const int rowb = u.pm * 256 + wr * 64 + fr;
#pragma unroll
        for (int ai = 0; ai < 2; ++ai)
#pragma unroll
            for (int m = 0; m < 4; ++m) { const int r = rowb + ai * 128 + m * 16;
#pragma unroll
                for (int bj = 0; bj < 2; ++bj) { __builtin_amdgcn_sched_barrier(0); const int c0 = u.pn * 256 + bj * 128 + wc * 32 + fq * 8; float v[8];
#pragma unroll
                    for (int e = 0; e < 8; ++e) v[e] = __builtin_amdgcn_rcpf(1.f + __builtin_amdgcn_exp2f(-1.4426950408889634f * acc[ai][bj][m][e >> 2][e & 3]));
                    *(u32x4*)(G + (size_t)r * 2048 + c0) = pack8(v); } }
    }
};
struct EpiP5 {
    static constexpr bool PERM = true, AFTER_DRAIN = false;
    u16* G; u16* Y;
    __device__ __forceinline__ void operator()(const f32x4 (&acc)[2][2][4][2], const pg8::Unit& u, int wr, int wc, int fr, int fq) const {
        const int rowb = u.pm * 256 + wr * 64 + fr;
        const bool sg = u.w == 0; u16* O = sg ? G : Y; const int ldc = sg ? 2048 : 1024;
#pragma unroll
        for (int ai = 0; ai < 2; ++ai)
#pragma unroll
            for (int m = 0; m < 4; ++m) { const int r = rowb + ai * 128 + m * 16;
#pragma unroll
                for (int bj = 0; bj < 2; ++bj) { const int c0 = u.pn * 256 + bj * 128 + wc * 32 + fq * 8; float v[8];
#pragma unroll
                    for (int e = 0; e < 8; ++e) { v[e] = acc[ai][bj][m][e >> 2][e & 3]; }
                    *(u32x4*)(O + (size_t)r * ldc + c0) = pack8(v); } }
    }
};
template <int ACT> struct EpiBf16 {
    static constexpr bool PERM = true, AFTER_DRAIN = false;
    u16* O; int ldc;
    __device__ __forceinline__ void operator()(const f32x4 (&acc)[2][2][4][2], const pg8::Unit& u, int wr, int wc, int fr, int fq) const {
        const int rowb = u.pm * 256 + wr * 64 + fr;
#pragma unroll
        for (int ai = 0; ai < 2; ++ai)
#pragma unroll
            for (int m = 0; m < 4; ++m) { const int r = rowb + ai * 128 + m * 16;
#pragma unroll
                for (int bj = 0; bj < 2; ++bj) { const int c0 = u.pn * 256 + bj * 128 + wc * 32 + fq * 8; float v[8];
#pragma unroll
                    for (int e = 0; e < 8; ++e) { float a = acc[ai][bj][m][e >> 2][e & 3]; if (ACT == 1) { a = fmaxf(a, 0.f); a = a * a; } v[e] = a; }
                    __builtin_nontemporal_store(pack8(v), (u32x4*)(O + (size_t)r * ldc + c0)); } }
    }
};
struct EpiMlp1 {
    static constexpr bool PERM = true, AFTER_DRAIN = false;
    u16* O; const float* SSP; const float* CB;
    __device__ __forceinline__ void operator()(const f32x4 (&acc)[2][2][4][2], const pg8::Unit& u, int wr, int wc, int fr, int fq) const {
        const int rowb = u.pm * 256 + wr * 64 + fr, b = (u.pm * 256) >> 13, cb = u.pn * 256 + wc * 32 + fq * 8;
        f32x4 cv[2][2];
#pragma unroll
        for (int bj = 0; bj < 2; ++bj)
#pragma unroll
            for (int n = 0; n < 2; ++n) cv[bj][n] = *(const f32x4*)(CB + b * 4096 + cb + bj * 128 + 4 * n);
        float rs[2][4];
#pragma unroll
        for (int ai = 0; ai < 2; ++ai)
#pragma unroll
            for (int m = 0; m < 4; ++m) rs[ai][m] = SSP[rowb + ai * 128 + m * 16];
        __builtin_amdgcn_sched_barrier(0);
#pragma unroll
        for (int ai = 0; ai < 2; ++ai)
#pragma unroll
            for (int m = 0; m < 4; ++m) { const int r = rowb + ai * 128 + m * 16;
#pragma unroll
                for (int bj = 0; bj < 2; ++bj) { float v[8];
#pragma unroll
                    for (int e = 0; e < 8; ++e) { float a = fmaxf(rs[ai][m] * acc[ai][bj][m][e >> 2][e & 3] + cv[bj][e >> 2][e & 3], 0.f); v[e] = a * a; }
                    __builtin_nontemporal_store(pack8(v), (u32x4*)(O + (size_t)r * 4096 + cb + bj * 128)); } }
    }
};
struct EpiMerge {
    static constexpr bool PERM = true, AFTER_DRAIN = false;
    const u16* G; const u16* YF; u16* O;
    __device__ __forceinline__ void operator()(const f32x4 (&acc)[2][2][4][2], const pg8::Unit& u, int wr, int wc, int fr, int fq) const {
        const int rowb = u.pm * 256 + wr * 64 + fr, cb = u.pn * 256 + wc * 32 + fq * 8;
#pragma unroll
        for (int ai = 0; ai < 2; ++ai)
#pragma unroll
            for (int mp = 0; mp < 2; ++mp) {
                u32x4 gf[2][2], ga[2][2], yf[2][2];
#pragma unroll
                for (int mm = 0; mm < 2; ++mm)
#pragma unroll
                    for (int bj = 0; bj < 2; ++bj) { const int r = rowb + ai * 128 + (2 * mp + mm) * 16, c0 = cb + bj * 128;
                        gf[mm][bj] = *(const u32x4*)(G + (size_t)r * 2048 + c0); ga[mm][bj] = *(const u32x4*)(G + (size_t)r * 2048 + 1024 + c0); yf[mm][bj] = *(const u32x4*)(YF + (size_t)r * 1024 + c0); }
                __builtin_amdgcn_sched_barrier(0);
#pragma unroll
                for (int mm = 0; mm < 2; ++mm)
#pragma unroll
                    for (int bj = 0; bj < 2; ++bj) { const int m = 2 * mp + mm, r = rowb + ai * 128 + m * 16, c0 = cb + bj * 128; float v[8];
#pragma unroll
                        for (int q = 0; q < 4; ++q) { v[2 * q] = sigm(bflo(gf[mm][bj][q])) * bflo(yf[mm][bj][q]) + sigm(bflo(ga[mm][bj][q])) * acc[ai][bj][m][q >> 1][(2 * q) & 3];
                            v[2 * q + 1] = sigm(bfhi(gf[mm][bj][q])) * bfhi(yf[mm][bj][q]) + sigm(bfhi(ga[mm][bj][q])) * acc[ai][bj][m][q >> 1][(2 * q + 1) & 3]; }
                        *(u32x4*)(O + (size_t)r * 1024 + c0) = pack8(v); }
                __builtin_amdgcn_sched_barrier(0);
            }
    }
};
struct EpiFused {
    static constexpr bool PERM = true, AFTER_DRAIN = false;
    u16* G; u16* O;
    __device__ __forceinline__ void operator()(const f32x4 (&acc)[2][2][4][2], const pg8::Unit& u, int wr, int wc, int fr, int fq) const {
        const int sub = u.w;
        if (sub == 0 || sub == 2 || sub == 4) return;
        const int rowb = u.pm * 256 + wr * 64 + fr, cb = u.pn * 256 + wc * 32 + fq * 8;
        if (sub == 1 || sub == 3) {
            u16* gp = G + (sub == 3 ? 1024 : 0);
#pragma unroll
            for (int ai = 0; ai < 2; ++ai)
#pragma unroll
                for (int m = 0; m < 4; ++m)
#pragma unroll
                    for (int bj = 0; bj < 2; ++bj) { float v[8];
#pragma unroll
                        for (int e = 0; e < 8; ++e) v[e] = acc[ai][bj][m][e >> 2][e & 3];
                        *(u32x4*)(gp + (size_t)(rowb + ai * 128 + m * 16) * 2048 + cb + bj * 128) = pack8(v); }
        } else if (sub == 5) {
#pragma unroll
            for (int ai = 0; ai < 2; ++ai) {
                u32x4 lf[4][2];
#pragma unroll
                for (int m = 0; m < 4; ++m)
#pragma unroll
                    for (int bj = 0; bj < 2; ++bj) lf[m][bj] = __builtin_nontemporal_load((const u32x4*)(G + (size_t)(rowb + ai * 128 + m * 16) * 2048 + cb + bj * 128));
                __builtin_amdgcn_sched_barrier(0);
#pragma unroll
                for (int m = 0; m < 4; ++m)
#pragma unroll
                    for (int bj = 0; bj < 2; ++bj) { float v[8];
#pragma unroll
                        for (int q = 0; q < 4; ++q) { v[2 * q] = acc[ai][bj][m][q >> 1][(2 * q) & 3] * sigm(bflo(lf[m][bj][q])); v[2 * q + 1] = acc[ai][bj][m][q >> 1][(2 * q + 1) & 3] * sigm(bfhi(lf[m][bj][q])); }
                        *(u32x4*)(G + (size_t)(rowb + ai * 128 + m * 16) * 2048 + cb + bj * 128) = pack8(v); }
                __builtin_amdgcn_sched_barrier(0);
            }
        } else {
#pragma unroll
            for (int ai = 0; ai < 2; ++ai)
#pragma unroll
                for (int mp = 0; mp < 2; ++mp) {
                    u32x4 pp[2][2], la[2][2];
#pragma unroll
                    for (int mm = 0; mm < 2; ++mm)
#pragma unroll
                        for (int bj = 0; bj < 2; ++bj) { const u16* gp = G + (size_t)(rowb + ai * 128 + (2 * mp + mm) * 16) * 2048 + cb + bj * 128; pp[mm][bj] = __builtin_nontemporal_load((const u32x4*)gp); la[mm][bj] = __builtin_nontemporal_load((const u32x4*)(gp + 1024)); }
                    __builtin_amdgcn_sched_barrier(0);
#pragma unroll
                    for (int mm = 0; mm < 2; ++mm)
#pragma unroll
                        for (int bj = 0; bj < 2; ++bj) { const int m = 2 * mp + mm; float v[8];
#pragma unroll
                            for (int q = 0; q < 4; ++q) { v[2 * q] = bflo(pp[mm][bj][q]) + acc[ai][bj][m][q >> 1][(2 * q) & 3] * sigm(bflo(la[mm][bj][q]));
                                v[2 * q + 1] = bfhi(pp[mm][bj][q]) + acc[ai][bj][m][q >> 1][(2 * q + 1) & 3] * sigm(bfhi(la[mm][bj][q])); }
                            *(u32x4*)(O + (size_t)(rowb + ai * 128 + m * 16) * 1024 + cb + bj * 128) = pack8(v); }
                    __builtin_amdgcn_sched_barrier(0);
                }
        }
    }
};
struct EpiX1 {
    static constexpr bool PERM = true, AFTER_DRAIN = false;
    u16* X; const float* gate; float* SSP;
    __device__ __forceinline__ void operator()(const f32x4 (&acc)[2][2][4][2], const pg8::Unit& u, int wr, int wc, int fr, int fq) const {
        const int rowb = u.pm * 256 + wr * 64 + fr, b = (u.pm * 256) >> 13, cb = u.pn * 256 + wc * 32 + fq * 8;
        f32x4 gt[2][2];
#pragma unroll
        for (int bj = 0; bj < 2; ++bj)
#pragma unroll
            for (int n = 0; n < 2; ++n) gt[bj][n] = *(const f32x4*)(gate + b * 6144 + cb + bj * 128 + 4 * n);
#pragma unroll
        for (int ai = 0; ai < 2; ++ai) {
            u32x4 xb[4][2];
#pragma unroll
            for (int m = 0; m < 4; ++m)
#pragma unroll
                for (int bj = 0; bj < 2; ++bj) xb[m][bj] = *(const u32x4*)(X + (size_t)(rowb + ai * 128 + m * 16) * 1024 + cb + bj * 128);
            __builtin_amdgcn_sched_barrier(0);
#pragma unroll
            for (int m = 0; m < 4; ++m) { float ssq = 0.f;
#pragma unroll
                for (int bj = 0; bj < 2; ++bj) { float v[8];
#pragma unroll
                    for (int q = 0; q < 4; ++q) { v[2 * q] = bflo(xb[m][bj][q]) + gt[bj][q >> 1][(2 * q) & 3] * acc[ai][bj][m][q >> 1][(2 * q) & 3];
                        v[2 * q + 1] = bfhi(xb[m][bj][q]) + gt[bj][q >> 1][(2 * q + 1) & 3] * acc[ai][bj][m][q >> 1][(2 * q + 1) & 3]; }
#pragma unroll
                    for (int e = 0; e < 8; ++e) ssq += v[e] * v[e];
                    *(u32x4*)(X + (size_t)(rowb + ai * 128 + m * 16) * 1024 + cb + bj * 128) = pack8(v); }
                ssq += __shfl_xor(ssq, 16); ssq += __shfl_xor(ssq, 32);
                if (fq == 0) SSP[(size_t)(rowb + ai * 128 + m * 16) * 16 + u.pn * 4 + wc] = ssq; }
            __builtin_amdgcn_sched_barrier(0);
        }
    }
};
struct EpiResid {
    static constexpr bool PERM = true, AFTER_DRAIN = false;
    const u16* base; float* out; const float* gate;
    __device__ __forceinline__ void operator()(const f32x4 (&acc)[2][2][4][2], const pg8::Unit& u, int wr, int wc, int fr, int fq) const {
        const int rowb = u.pm * 256 + wr * 64 + fr, b = (u.pm * 256) >> 13, cb = u.pn * 256 + wc * 32 + fq * 8;
        f32x4 gt[2][2];
#pragma unroll
        for (int bj = 0; bj < 2; ++bj)
#pragma unroll
            for (int n = 0; n < 2; ++n) gt[bj][n] = *(const f32x4*)(gate + b * 6144 + cb + bj * 128 + 4 * n);
        u32x4 xb[2][4][2];
#pragma unroll
        for (int ai = 0; ai < 2; ++ai)
#pragma unroll
            for (int m = 0; m < 4; ++m)
#pragma unroll
                for (int bj = 0; bj < 2; ++bj) xb[ai][m][bj] = __builtin_nontemporal_load((const u32x4*)(base + (size_t)(rowb + ai * 128 + m * 16) * 1024 + cb + bj * 128));
        __builtin_amdgcn_sched_barrier(0);
#pragma unroll
        for (int ai = 0; ai < 2; ++ai)
#pragma unroll
            for (int m = 0; m < 4; ++m)
#pragma unroll
                for (int bj = 0; bj < 2; ++bj)
#pragma unroll
                    for (int n = 0; n < 2; ++n) { f32x4 x; x[0] = bflo(xb[ai][m][bj][2 * n]); x[1] = bfhi(xb[ai][m][bj][2 * n]); x[2] = bflo(xb[ai][m][bj][2 * n + 1]); x[3] = bfhi(xb[ai][m][bj][2 * n + 1]);
                        *(f32x4*)(out + (size_t)(rowb + ai * 128 + m * 16) * 1024 + cb + bj * 128 + 4 * n) = x + gt[bj][n] * acc[ai][bj][m][n]; }
    }
};

template <class Epi> DI void run_gemm2(LAS unsigned char* lds, const u16* A, const u16* Bt, int M, int N, const u16* A2, const u16* Bt2, int M2, int N2, int K, const Epi& E) {
    pg8::Gemm g; g.A = A; g.Bt = Bt; g.M = M; g.N = N; g.K = K; g.A2 = A2; g.Bt2 = Bt2; g.M2 = M2; g.N2 = N2; g.KL = 0;
    pg8::DualOrder S; S.init(M, N, M2, N2, (int)gridDim.x, (int)blockIdx.x);
    pg8::gemm_phase<Epi, pg8::DualOrder, false>(lds, g, S, E, nullptr);
}
template <class Epi> DI void run_gemm(LAS unsigned char* lds, const u16* A, const u16* Bt, int M, int N, int K, const Epi& E) { run_gemm2(lds, A, Bt, M, N, A, Bt, 0, 0, K, E); }

DI void phase_ada(const Params& p, unsigned char* smem) {
    float* sm = (float*)smem;
    float* sl = sm; float* red = sm + 5120;
    const int tid = threadIdx.x;
    unsigned char* ws = p.ws;
    for (int i = tid; i < 5120; i += 512) { const int v = i >> 10, k = i & 1023; const float cv = v < 4 ? p.in[1][v * 1024 + k] : p.in[3][k]; sl[i] = cv / (1.f + __expf(-cv)); }
    if (blockIdx.x == 0 && tid < 128) ((float*)(ws + WS_QKG))[tid] = tid < 64 ? p.in[9][tid] * (0.125f * 1.4426950408889634f) : p.in[10][tid - 64];
    __syncthreads();
    float* ada = (float*)(ws + WS_ADA);
    for (int item = blockIdx.x; item < 256; item += gridDim.x) {
        const int q4 = tid % 6, kc = tid / 6;
        if (kc < 85) { float4 wv[13];
#pragma unroll
            for (int s = 0; s < 13; ++s) { const int k = kc + 85 * s; if (k < 1024) { const f32x4 t = __builtin_nontemporal_load((const f32x4*)(p.in[4] + (size_t)k * 6144 + item * 24 + 4 * q4)); wv[s] = make_float4(t[0], t[1], t[2], t[3]); } else wv[s] = make_float4(0.f, 0.f, 0.f, 0.f); }
            float a[5][4];
#pragma unroll
            for (int v = 0; v < 5; ++v) { a[v][0] = 0.f; a[v][1] = 0.f; a[v][2] = 0.f; a[v][3] = 0.f; }
#pragma unroll
            for (int s = 0; s < 13; ++s) { const int k = min(kc + 85 * s, 1023);
#pragma unroll
                for (int v = 0; v < 5; ++v) { const float sv = sl[v * 1024 + k]; a[v][0] += sv * wv[s].x; a[v][1] += sv * wv[s].y; a[v][2] += sv * wv[s].z; a[v][3] += sv * wv[s].w; } }
#pragma unroll
            for (int v = 0; v < 5; ++v)
#pragma unroll
                for (int c = 0; c < 4; ++c) red[(v * 85 + kc) * 24 + 4 * q4 + c] = a[v][c]; }
        __syncthreads();
        if (tid < 120) { const int v = tid / 24, j2 = tid % 24; float s = 0.f; for (int q = 0; q < 85; ++q) s += red[(v * 85 + q) * 24 + j2]; ada[v * 6144 + item * 24 + j2] = s + p.in[5][item * 24 + j2]; }
        __syncthreads();
    }
}
DI void phase_prep_rest(const Params& p, unsigned char* smem) {
    float* sm = (float*)smem; float* ctab = sm + 7680; float* tl = sm + 8192;
    const int tid = threadIdx.x; unsigned char* ws = p.ws;
    if (tid < 128) ctab[tid] = cospif((float)tid * (1.f / 64.f));
    __syncthreads();
    { float2* rope = (float2*)(ws + WS_ROPE); u16* F1 = (u16*)(ws + WS_F1); u16* F2K = (u16*)(ws + WS_F2K);
      for (int i = blockIdx.x * 512 + tid; i < 2048 + 8192; i += gridDim.x * 512) {
          if (i < 2048) { const int pos = i >> 4, jf = i & 15; const float invf = powf(10000.f, -(float)jf * (1.f / 16.f)); const float ang = (float)pos * invf; rope[i] = make_float2(cosf(ang), sinf(ang)); }
          else { const int q = i - 2048, r = q >> 6, n2 = q & 63, k2 = r & 63; const float a = (float)((k2 * n2) & 63) * (1.f / 32.f); F1[q] = f2bf(r < 64 ? cospif(a) : -sinpif(a)); }
      }
      for (int i = blockIdx.x * 512 + tid; i < 64 * 65536 / 2; i += gridDim.x * 512) {
          const int e0 = 2 * i, k2 = e0 >> 16, r = (e0 >> 8) & 255, k1 = r & 127; float v[2];
#pragma unroll
          for (int h = 0; h < 2; ++h) { const int cidx = (e0 & 255) + h, n1 = cidx & 127; const float a = (float)((n1 * (64 * k1 + k2)) & 8191) * (1.f / 4096.f);
              const bool wc = (r < 128) == (cidx < 128); float x = wc ? cospif(a) : sinpif(a); if (r >= 128 && cidx < 128) x = -x; v[h] = x; }
          *(unsigned*)(F2K + e0) = pk2(v[0], v[1]);
      } }
    { u16* dst = (u16*)(ws + WS_WFO); const float* wfo = p.in[13];
      for (int item = blockIdx.x; item < 128; item += gridDim.x) {
          const int g = item >> 5, jblk = (item >> 1) & 15, half = item & 1, j = jblk * 64 + (tid & 63), kc = half * 8 + (tid >> 6);
          float ac[8], as[8];
#pragma unroll
          for (int e = 0; e < 8; ++e) { ac[e] = 0.f; as[e] = 0.f; }
          for (int kp0 = 0; kp0 < 128; kp0 += 32) { float wv[32];
#pragma unroll
              for (int q = 0; q < 32; ++q) wv[q] = wfo[(size_t)(g * 128 + kp0 + q) * 1024 + j];
#pragma unroll
              for (int q = 0; q < 32; ++q) { const int kp = kp0 + q; const float w = wv[q];
#pragma unroll
                  for (int e = 0; e < 8; ++e) { const int idx = ((kc * 8 + e) * kp) & 127; ac[e] += ctab[idx] * w; as[e] += ctab[(idx - 32) & 127] * w; } } }
          *(u32x4*)(dst + (size_t)j * 1024 + g * 128 + kc * 8) = pack8(ac);
          *(u32x4*)(dst + (size_t)j * 1024 + 512 + g * 128 + kc * 8) = pack8(as);
      } }
    {
        auto tile_info = [&](int ti, const float*& src, u16*& dst, int& K, int& N, int& n0, int& k0, int& map, int& dp) {
            int tl_i; map = 0; dp = 0;
            if (ti < 128) { src = p.in[8]; dst = (u16*)(ws + WS_WIN); K = 1024; N = 2048; tl_i = ti; map = 1; }
            else if (ti < 256) { src = p.in[12]; dst = (u16*)(ws + WS_WGATE); K = 1024; N = 2048; tl_i = ti - 128; }
            else if (ti < 288) { src = p.in[14]; dst = (u16*)(ws + WS_WAO); K = 512; N = 1024; tl_i = ti - 256; dp = 1024; }
            else if (ti < 352) { src = p.in[15]; dst = (u16*)(ws + WS_WO); K = 1024; N = 1024; tl_i = ti - 288; }
            else if (ti < 608) { src = p.in[16]; dst = (u16*)(ws + WS_W1); K = 1024; N = 4096; tl_i = ti - 352; }
            else { src = p.in[17]; dst = (u16*)(ws + WS_W2); K = 4096; N = 1024; tl_i = ti - 608; }
            const int nkt = K >> 8; n0 = (tl_i / nkt) * 64; k0 = (tl_i % nkt) * 256; if (!dp) dp = K; };
        const int nn = tid & 63, kq = tid >> 6, n4 = tid & 15, kr = tid >> 4;
        float r[32];
#define TR_LOAD(SRC, K0, NN, N0, MAP) do { if (MAP) { const int col_ = win_src_col((N0) + nn); _Pragma("unroll") for (int e = 0; e < 32; ++e) r[e] = __builtin_nontemporal_load((SRC) + (size_t)((K0) + kq + 8 * e) * (NN) + col_); } \
            else { _Pragma("unroll") for (int e = 0; e < 8; ++e) { const f32x4 t_ = __builtin_nontemporal_load((const f32x4*)((SRC) + (size_t)((K0) + kr + 32 * e) * (NN) + (N0) + 4 * n4)); r[4 * e] = t_[0]; r[4 * e + 1] = t_[1]; r[4 * e + 2] = t_[2]; r[4 * e + 3] = t_[3]; } } } while (0)
        int ti = blockIdx.x;
        if (ti < 864) { const float* src; u16* dst; int K, N, n0, k0, map, dp; tile_info(ti, src, dst, K, N, n0, k0, map, dp); TR_LOAD(src, k0, N, n0, map); }
        for (; ti < 864; ti += gridDim.x) {
            const float* src; u16* dst; int K, N, n0, k0, map, dp; tile_info(ti, src, dst, K, N, n0, k0, map, dp);
            if (map) {
#pragma unroll
                for (int e = 0; e < 32; ++e) tl[(kq + 8 * e) * 65 + nn] = r[e];
            } else {
#pragma unroll
                for (int e = 0; e < 8; ++e) {
#pragma unroll
                    for (int c = 0; c < 4; ++c) tl[(kr + 32 * e) * 65 + 4 * n4 + c] = r[4 * e + c]; }
            }
            const int tn = ti + (int)gridDim.x;
            if (tn < 864) { const float* s2; u16* d2; int K2, N2, n2, k2, m2, dp2; tile_info(tn, s2, d2, K2, N2, n2, k2, m2, dp2); TR_LOAD(s2, k2, N2, n2, m2); }
            __syncthreads();
#pragma unroll
            for (int e = 0; e < 16; ++e) { const int idx = tid + 512 * e, n2 = idx >> 7, kp = idx & 127; *(unsigned*)(dst + (size_t)(n0 + n2) * dp + k0 + 2 * kp) = pk2(tl[(2 * kp) * 65 + n2], tl[(2 * kp + 1) * 65 + n2]); }
            __syncthreads();
        }
    }
}

template <bool BF16IN> DI void rows4(const float* const (&xs)[4], const u16* const (&ds)[4], u16* const (&os)[4], u16* const (&hs)[4], const bool (&ok)[4],
                                  const float* gn, const float* sh, const float* sc, int lane) {
    float4 v[4][4]; u32x2 d[4][4]; float4 g[4], s[4], q[4];
#pragma unroll
    for (int r = 0; r < 4; ++r) if (ok[r]) {
#pragma unroll
        for (int i = 0; i < 4; ++i) { if (BF16IN) d[r][i] = *(const u32x2*)(ds[r] + 4 * lane + 256 * i); else { const f32x4 t = __builtin_nontemporal_load((const f32x4*)(xs[r] + 4 * lane + 256 * i)); v[r][i] = make_float4(t[0], t[1], t[2], t[3]); } } }
#pragma unroll
    for (int i = 0; i < 4; ++i) { const int c = 4 * lane + 256 * i; g[i] = *(const float4*)(gn + c); s[i] = *(const float4*)(sh + c); q[i] = *(const float4*)(sc + c); }
    __builtin_amdgcn_sched_barrier(0);
#pragma unroll
    for (int r = 0; r < 4; ++r) if (ok[r]) {
        float ss = 0.f;
#pragma unroll
        for (int i = 0; i < 4; ++i) { if (BF16IN) { v[r][i].x = bflo(d[r][i][0]); v[r][i].y = bfhi(d[r][i][0]); v[r][i].z = bflo(d[r][i][1]); v[r][i].w = bfhi(d[r][i][1]); }
            ss += v[r][i].x * v[r][i].x + v[r][i].y * v[r][i].y + v[r][i].z * v[r][i].z + v[r][i].w * v[r][i].w; }
        ss = wave_sum(ss);
        const float rstd = __builtin_amdgcn_rsqf(ss * (1.f / 1024.f) + 1e-6f);
#pragma unroll
        for (int i = 0; i < 4; ++i) { const int c = 4 * lane + 256 * i;
            if (!BF16IN && os[r]) { u32x2 xo; xo[0] = pk2(v[r][i].x, v[r][i].y); xo[1] = pk2(v[r][i].z, v[r][i].w); __builtin_nontemporal_store(xo, (u32x2*)(os[r] + c)); }
            u32x2 o; o[0] = pk2(v[r][i].x * rstd * g[i].x * (1.f + q[i].x) + s[i].x, v[r][i].y * rstd * g[i].y * (1.f + q[i].y) + s[i].y);
            o[1] = pk2(v[r][i].z * rstd * g[i].z * (1.f + q[i].z) + s[i].z, v[r][i].w * rstd * g[i].w * (1.f + q[i].w) + s[i].w);
            *(u32x2*)(hs[r] + c) = o; } }
}

DI bf16x8 gather8(const u16* p, size_t stride) {
    u32x4 r;
#pragma unroll
    for (int q = 0; q < 4; ++q) { const unsigned lo = p[(size_t)(2 * q) * stride], hi = p[(size_t)(2 * q + 1) * stride]; r[q] = lo | (hi << 16); }
    return __builtin_bit_cast(bf16x8, r);
}
DI void phase_fft1(const Params& p, unsigned char* smem, int wg, int nwg) {
    const int tid = threadIdx.x, lane = tid & 63, wave = tid >> 6, l31 = lane & 31, g = lane >> 5;
    const u16* U = (const u16*)(p.ws + WS_F); u16* T1 = (u16*)(p.ws + WS_T1); const u16* F1 = (const u16*)(p.ws + WS_F1);
    u16* tile = (u16*)smem;
    bf16x8 ff[4][4];
#pragma unroll
    for (int mt = 0; mt < 4; ++mt)
#pragma unroll
        for (int ks = 0; ks < 4; ++ks) ff[mt][ks] = *(const bf16x8*)(F1 + (32 * mt + l31) * 64 + 16 * ks + 8 * g);
    const int me = l31 & 3, mg = (l31 >> 2) & 1, mq = l31 >> 3, n1i = (mq & 1) * 4 + me, cj = (mq >> 1) * 2 + mg;
    for (int wt = wg; wt < 512; wt += nwg) {
        const int b = wt >> 7, n1_0 = ((wt >> 3) & 15) * 8, c0 = (wt & 7) * 64;
        u32x4 r[8];
#pragma unroll
        for (int e = 0; e < 8; ++e) { const int q = tid + 512 * e, row = q >> 3, piece = q & 7, n2 = row >> 3, ni = row & 7;
            r[e] = __builtin_nontemporal_load((const u32x4*)(U + ((size_t)(b * SEQ + n1_0 + ni + 128 * n2)) * 512 + c0 + piece * 8)); }
#pragma unroll
        for (int e = 0; e < 8; ++e) { const int q = tid + 512 * e, row = q >> 3, piece = q & 7; u32x2 lo, hi; lo[0] = r[e][0]; lo[1] = r[e][1]; hi[0] = r[e][2]; hi[1] = r[e][3];
            *(u32x2*)(tile + row * 68 + piece * 8) = lo; *(u32x2*)(tile + row * 68 + piece * 8 + 4) = hi; }
        __syncthreads();
#pragma unroll
        for (int tt = 0; tt < 2; ++tt) {
            const int cb = (2 * wave + tt) * 4;
            bf16x8 fa[4];
#pragma unroll
            for (int ks = 0; ks < 4; ++ks) fa[ks] = gather8(tile + ((16 * ks + 8 * g) * 8 + n1i) * 68 + cb + cj, 8 * 68);
#pragma unroll
            for (int mt = 0; mt < 4; ++mt) { f32x16 acc;
#pragma unroll
                for (int i = 0; i < 16; ++i) acc[i] = 0.f;
#pragma unroll
                for (int ks = 0; ks < 4; ++ks) acc = MFMA32(fa[ks], ff[mt][ks], acc);
                const int ri = mt >> 1, k2 = 32 * (mt & 1) + l31;
                u16* o = T1 + ((((size_t)(b * 64 + k2) * 2 + ri) * 512 + c0 + cb + g) * 128 + n1_0);
                float v[16];
#pragma unroll
                for (int i = 0; i < 16; ++i) v[i] = acc[i];
                *(u32x4*)(o) = pack8(v); *(u32x4*)(o + 2 * 128) = pack8(v + 8); }
        }
        __syncthreads();
    }
}
DI void phase_fft2(const Params& p, unsigned char* smem) {
    const int tid = threadIdx.x, lane = tid & 63, wave = tid >> 6, l31 = lane & 31, g = lane >> 5;
    const u16* T1 = (const u16*)(p.ws + WS_T1); u16* Z = (u16*)(p.ws + WS_Z); const u16* F2K = (const u16*)(p.ws + WS_F2K);
    u16* buf = (u16*)smem;
    const int cperm = 16 * ((l31 >> 2) & 1) + 4 * (l31 >> 3) + (l31 & 3);
    for (int wt = blockIdx.x; wt < 256; wt += gridDim.x) {
        const int b = wt >> 6, k2 = wt & 63;
        bf16x8 ff[16];
#pragma unroll
        for (int ks = 0; ks < 16; ++ks) ff[ks] = *(const bf16x8*)(F2K + ((size_t)(k2 * 256 + 32 * wave + l31)) * 256 + 16 * ks + 8 * g);
        const u16* slab = T1 + ((size_t)(b * 64 + k2) * 2) * 512 * 128;
        u32x4 st[4];
#pragma unroll
        for (int e = 0; e < 4; ++e) { const int q = tid + 512 * e, row = q >> 4, piece = q & 15, ri = row >> 6, cl = row & 63; st[e] = *(const u32x4*)(slab + ((size_t)(ri * 512 + cl)) * 128 + piece * 8); }
#pragma unroll
        for (int e = 0; e < 4; ++e) { const int q = tid + 512 * e, row = q >> 4, piece = q & 15; *(u32x4*)(buf + row * 136 + piece * 8) = st[e]; }
        __syncthreads();
        for (int cch = 0; cch < 8; ++cch) {
            if (cch + 1 < 8) {
#pragma unroll
                for (int e = 0; e < 4; ++e) { const int q = tid + 512 * e, row = q >> 4, piece = q & 15, ri = row >> 6, cl = row & 63; st[e] = *(const u32x4*)(slab + ((size_t)(ri * 512 + (cch + 1) * 64 + cl)) * 128 + piece * 8); }
            }
            const u16* cb = buf + (cch & 1) * (128 * 136);
            f32x16 acc0, acc1;
#pragma unroll
            for (int i = 0; i < 16; ++i) { acc0[i] = 0.f; acc1[i] = 0.f; }
#pragma unroll
            for (int ks = 0; ks < 16; ++ks) { const u16* ap = cb + ((ks >> 3) * 64 + cperm) * 136 + 16 * (ks & 7) + 8 * g;
                const bf16x8 fa0 = *(const bf16x8*)ap, fa1 = *(const bf16x8*)(ap + 32 * 136); acc0 = MFMA32(fa0, ff[ks], acc0); acc1 = MFMA32(fa1, ff[ks], acc1); }
            { const int ri = wave >> 2, k1 = 32 * (wave & 3) + l31;
              u16* o = Z + ((size_t)(b * SEQ + 64 * k1 + k2)) * 1024 + ri * 512 + cch * 64 + 16 * g;
              float v[16], w[16];
#pragma unroll
              for (int i = 0; i < 16; ++i) { v[i] = acc0[i] * (1.f / 1024.f); w[i] = acc1[i] * (1.f / 1024.f); }
              *(u32x4*)(o) = pack8(v); *(u32x4*)(o + 8) = pack8(v + 8); *(u32x4*)(o + 32) = pack8(w); *(u32x4*)(o + 40) = pack8(w + 8); }
            if (cch + 1 < 8) {
                u16* nb = buf + ((cch + 1) & 1) * (128 * 136);
#pragma unroll
                for (int e = 0; e < 4; ++e) { const int q = tid + 512 * e, row = q >> 4, piece = q & 15; *(u32x4*)(nb + row * 136 + piece * 8) = st[e]; }
            }
            __syncthreads();
        }
    }
}

DI void phase_attn(const Params& p, LAS unsigned char* lds) {
    LAS float* rp = (LAS float*)lds;
    LAS u16* ckl = (LAS u16*)(lds + 16384);
    LAS u16* cvl = (LAS u16*)(lds + 16384 + 36864);
    const int tid = threadIdx.x;
    for (int i = tid; i < 4096; i += 512) { const int j = i - 128; rp[i] = (j >= 0 && j < 3720) ? p.in[11][j] * 1.4426950408889634f : 0.f; }
    const int lane = tid & 63, wave = tid >> 6, n = lane & 31, g = lane >> 5;
    const u16* Qg = (const u16*)(p.ws + WS_Q); const u16* Kg = (const u16*)(p.ws + WS_K); const u16* VTg = (const u16*)(p.ws + WS_V);
    const u16* CK = (const u16*)(p.ws + WS_CTXK); const u16* CVT = (const u16*)(p.ws + WS_CTXV); u16* Y = (u16*)(p.ws + WS_YATT);
    for (int it = blockIdx.x; it < 512; it += gridDim.x) {
        const int bh = it >> 4, band = it & 15, hd = bh & 7, b = bh >> 3;
        __syncthreads();
        {
            u32x4 rk[4], rv[4];
#pragma unroll
            for (int e = 0; e < 4; ++e) { const int q = tid + 512 * e; rk[e] = *(const u32x4*)(CK + (size_t)bh * CTXL * 64 + (size_t)q * 8); rv[e] = *(const u32x4*)(CVT + (size_t)bh * 64 * CTXL + (size_t)q * 8); }
#pragma unroll
            for (int e = 0; e < 4; ++e) { const int q = tid + 512 * e; *(LAS u32x4*)(ckl + (q >> 3) * 72 + (q & 7) * 8) = rk[e]; *(LAS u32x4*)(cvl + (q >> 5) * 264 + (q & 31) * 8) = rv[e]; }
        }
        __syncthreads();
        {
        const int ct = wave & 3, r0 = 2 * (band * 4 + (wave >> 2) * 2);
        const int qi = n & 15, qrA = r0 + (n >> 4), qrB = qrA + 2;
        const int qcol = ct == 0 ? (qi < 8 ? qi : 48 + qi) : 8 + 16 * (ct - 1) + qi;
        const int h0 = ct == 0 ? 0 : 16 * (ct - 1), h1 = ct == 0 ? 48 : 16 * ct;
        const int cs = min(max(qcol - 8, 0), 48);
        const int rsA = min(max(qrA - 4, 0), 120), rsB = min(max(qrB - 4, 0), 120);
        const int kbeg = min(max(r0 - 4, 0), 120), kend = min(max(r0 - 1, 0), 120) + 8;
        const int wA0 = kbeg, wA1 = min(max(r0 - 3, 0), 120) + 8, wB0 = min(max(r0 - 2, 0), 120), wB1 = kend;
        bf16x8 qA[4], qB[4];
        { const u16* qp = Qg + ((size_t)bh * SEQ + qrA * 64 + qcol) * 64 + 8 * g;
#pragma unroll
          for (int ks = 0; ks < 4; ++ks) { qA[ks] = *(const bf16x8*)(qp + 16 * ks); qB[ks] = *(const bf16x8*)(qp + 2 * 64 * 64 + 16 * ks); } }
        float cneg[16];
#pragma unroll
        for (int i = 0; i < 16; ++i) { const int kcol = (i < 8 ? h0 : h1) + ((i >> 2) & 1) * 8 + 4 * g + (i & 3); cneg[i] = (kcol >= cs && kcol < cs + 16) ? 0.f : -1e30f; }
        const int bbase = 128 + hd * 465 + 7 * 31 + 4 * g - qcol + 15;
        const int kcolm = (n < 16 ? h0 : h1) + (n & 15);
        const u16* Kb = Kg + (size_t)bh * SEQ * 64 + (size_t)kcolm * 64 + 8 * g;
        const u16* Vb = VTg + ((size_t)bh * 64 + n) * SEQ + 8 * g;
        f32x16 OA[2], OB[2];
#pragma unroll
        for (int i = 0; i < 16; ++i) { OA[0][i] = 0.f; OA[1][i] = 0.f; OB[0][i] = 0.f; OB[1][i] = 0.f; }
        float lA = 0.f, lB = 0.f;
#pragma unroll 1
        for (int kr = kbeg; kr < kend; ++kr) {
            bf16x8 kf[4], vf[2][2];
#pragma unroll
            for (int ks = 0; ks < 4; ++ks) kf[ks] = *(const bf16x8*)(Kb + (size_t)kr * 64 * 64 + 16 * ks);
#pragma unroll
            for (int s2 = 0; s2 < 2; ++s2)
#pragma unroll
                for (int mt = 0; mt < 2; ++mt) vf[s2][mt] = *(const bf16x8*)(Vb + (size_t)mt * 32 * SEQ + kr * 64 + (s2 ? h1 : h0));
            const int bidx = bbase + (kr - qrA) * 31;
            if (kr >= wA0 && kr < wA1) {
                const float negrow = ((kr >= rsA) && (kr < rsA + 8)) ? 0.f : -1e30f;
                f32x16 S;
#pragma unroll
                for (int i = 0; i < 16; ++i) S[i] = 0.f;
#pragma unroll
                for (int ks = 0; ks < 4; ++ks) S = MFMA32(kf[ks], qA[ks], S);
                float P[16];
#pragma unroll
                for (int i = 0; i < 16; ++i) { const int off = (i < 8 ? h0 : h1) + ((i >> 2) & 1) * 8 + (i & 3);
                    const float sv = (S[i] + rp[bidx + off]) + (cneg[i] + negrow); const float pv = __builtin_amdgcn_exp2f(sv); lA += pv; P[i] = pv; }
                const bf16x8 pb0 = __builtin_bit_cast(bf16x8, pack8(P)), pb1 = __builtin_bit_cast(bf16x8, pack8(P + 8));
#pragma unroll
                for (int mt = 0; mt < 2; ++mt) { OA[mt] = MFMA32(vf[0][mt], pb0, OA[mt]); OA[mt] = MFMA32(vf[1][mt], pb1, OA[mt]); }
            }
            if (kr >= wB0 && kr < wB1) {
                const float negrow = ((kr >= rsB) && (kr < rsB + 8)) ? 0.f : -1e30f;
                f32x16 S;
#pragma unroll
                for (int i = 0; i < 16; ++i) S[i] = 0.f;
#pragma unroll
                for (int ks = 0; ks < 4; ++ks) S = MFMA32(kf[ks], qB[ks], S);
                float P[16];
#pragma unroll
                for (int i = 0; i < 16; ++i) { const int off = (i < 8 ? h0 : h1) + ((i >> 2) & 1) * 8 + (i & 3);
                    const float sv = (S[i] + rp[bidx - 62 + off]) + (cneg[i] + negrow); const float pv = __builtin_amdgcn_exp2f(sv); lB += pv; P[i] = pv; }
                const bf16x8 pb0 = __builtin_bit_cast(bf16x8, pack8(P)), pb1 = __builtin_bit_cast(bf16x8, pack8(P + 8));
#pragma unroll
                for (int mt = 0; mt < 2; ++mt) { OB[mt] = MFMA32(vf[0][mt], pb0, OB[mt]); OB[mt] = MFMA32(vf[1][mt], pb1, OB[mt]); }
            }
        }
#pragma unroll 1
        for (int kt = 0; kt < 8; ++kt) {
            bf16x8 ck[4], cv[2][2];
#pragma unroll
            for (int ks = 0; ks < 4; ++ks) ck[ks] = *(const LAS bf16x8*)(ckl + (32 * kt + n) * 72 + 16 * ks + 8 * g);
#pragma unroll
            for (int s2 = 0; s2 < 2; ++s2)
#pragma unroll
                for (int mt = 0; mt < 2; ++mt) cv[s2][mt] = *(const LAS bf16x8*)(cvl + (32 * mt + n) * 264 + 32 * kt + 16 * s2 + 8 * g);
            f32x16 SA, SB;
#pragma unroll
            for (int i = 0; i < 16; ++i) { SA[i] = 0.f; SB[i] = 0.f; }
#pragma unroll
            for (int ks = 0; ks < 4; ++ks) { SA = MFMA32(ck[ks], qA[ks], SA); SB = MFMA32(ck[ks], qB[ks], SB); }
            float PA[16], PB[16];
#pragma unroll
            for (int i = 0; i < 16; ++i) { const float ea = __builtin_amdgcn_exp2f(SA[i]), eb = __builtin_amdgcn_exp2f(SB[i]); lA += ea; lB += eb; PA[i] = ea; PB[i] = eb; }
            const bf16x8 a0 = __builtin_bit_cast(bf16x8, pack8(PA)), a1 = __builtin_bit_cast(bf16x8, pack8(PA + 8)), b0 = __builtin_bit_cast(bf16x8, pack8(PB)), b1 = __builtin_bit_cast(bf16x8, pack8(PB + 8));
#pragma unroll
            for (int mt = 0; mt < 2; ++mt) { OA[mt] = MFMA32(cv[0][mt], a0, OA[mt]); OB[mt] = MFMA32(cv[0][mt], b0, OB[mt]); OA[mt] = MFMA32(cv[1][mt], a1, OA[mt]); OB[mt] = MFMA32(cv[1][mt], b1, OB[mt]); }
        }
        lA += __shfl_xor(lA, 32); lB += __shfl_xor(lB, 32);
        const float iA = 1.f / lA, iB = 1.f / lB;
        u16* yo = Y + ((size_t)b * SEQ + qrA * 64 + qcol) * 1024 + hd * 64 + 4 * g;
#pragma unroll
        for (int mt = 0; mt < 2; ++mt)
#pragma unroll
            for (int q = 0; q < 4; ++q) { u32x2 o; o[0] = pk2(OA[mt][4 * q] * iA, OA[mt][4 * q + 1] * iA); o[1] = pk2(OA[mt][4 * q + 2] * iA, OA[mt][4 * q + 3] * iA);
                *(u32x2*)(yo + 32 * mt + 8 * q) = o;
                u32x2 o2; o2[0] = pk2(OB[mt][4 * q] * iB, OB[mt][4 * q + 1] * iB); o2[1] = pk2(OB[mt][4 * q + 2] * iB, OB[mt][4 * q + 3] * iB);
                *(u32x2*)(yo + (size_t)2 * 64 * 1024 + 32 * mt + 8 * q) = o2; }
        }
    }
    __syncthreads();
}


#define XB_TMO      128
#define XB_XCNT(j)  (256  + 64 * (j))
#define XB_XSUB(j)  (1280 + 64 * (j))
#define XB_XGEN(j)  (2304 + 64 * (j))
#define XB_TOP      3328
#define XB_TOPGEN   3392
#define XCD_BAR_WORDS 3456
#define XB_SPIN_CAP (1u << 18)

__device__ __forceinline__ unsigned xb_ld(unsigned* p)              { return __hip_atomic_load(p, __ATOMIC_RELAXED, __HIP_MEMORY_SCOPE_AGENT); }
__device__ __forceinline__ unsigned xb_add(unsigned* p, unsigned v) { return __hip_atomic_fetch_add(p, v, __ATOMIC_RELAXED, __HIP_MEMORY_SCOPE_AGENT); }
__device__ __forceinline__ unsigned xb_xcc_id() { return (unsigned)__builtin_amdgcn_s_getreg((3 << 11) | 20) & 0xFu; }
#define XB_SPIN(cond, bar) do { unsigned _sp = 0; while (cond) { __builtin_amdgcn_s_sleep(1); \
    if ((++_sp & 255u) == 0u) { if (xb_ld(&(bar)[XB_TMO])) break; if (_sp > XB_SPIN_CAP) { atomicAdd(&(bar)[XB_TMO], 1u); break; } } } } while (0)

struct XcdBarrier {
    unsigned* bar; unsigned x;
    volatile LAS unsigned* st;
};

__device__ __forceinline__ XcdBarrier xcd_barrier_post(unsigned* bar, volatile LAS unsigned* st) {
    XcdBarrier b; b.bar = bar; b.x = xb_xcc_id(); b.st = st;
    if (threadIdx.x == 0) (void)xb_add(&bar[XB_XCNT(b.x)], 1u);
    return b;
}
__device__ __forceinline__ void xcd_barrier_complete(unsigned* bar, unsigned x, unsigned& nloc, unsigned& nx) {
    const unsigned G = gridDim.x * gridDim.y * gridDim.z;
    unsigned sum, cnt, mine, sp = 0u;
    for (;;) {
        sum = 0u; cnt = 0u; mine = 0u;
#pragma unroll
        for (unsigned j = 0; j < 16; ++j) { const unsigned c = xb_ld(&bar[XB_XCNT(j)]); sum += c; cnt += (c > 0u) ? 1u : 0u; mine = (j == x) ? c : mine; }
        if (sum == G) break;
        __builtin_amdgcn_s_sleep(1);
        if ((++sp & 255u) == 0u) { if (xb_ld(&bar[XB_TMO])) break; if (sp > XB_SPIN_CAP) { atomicAdd(&bar[XB_TMO], 1u); break; } }
    }
    nloc = mine > 0u ? mine : 1u; nx = cnt > 0u ? cnt : 1u;
}

__device__ __forceinline__ void xcd_barrier(const XcdBarrier& b) {
    asm volatile("s_waitcnt vmcnt(0)" ::: "memory");
    __syncthreads();
    if (threadIdx.x == 0) {
        unsigned* bar = b.bar;
        __builtin_amdgcn_s_waitcnt(0);
        unsigned nloc = b.st[0], nx = b.st[1];
        if (nloc == 0u) { xcd_barrier_complete(bar, b.x, nloc, nx); b.st[0] = nloc; b.st[1] = nx; }
        const unsigned old = xb_add(&bar[XB_XSUB(b.x)], 1u);
        const unsigned gen = old / nloc;
        if (old + 1u == (gen + 1u) * nloc) {
            __builtin_amdgcn_fence(__ATOMIC_RELEASE, "agent");
            asm volatile("s_waitcnt vmcnt(0)" ::: "memory");
            const unsigned og = xb_add(&bar[XB_TOP], 1u);
            const unsigned tg = og / nx;
            if (og + 1u == (tg + 1u) * nx) xb_add(&bar[XB_TOPGEN], 1u);
            else XB_SPIN(xb_ld(&bar[XB_TOPGEN]) == tg, bar);
            __builtin_amdgcn_fence(__ATOMIC_ACQUIRE, "agent");
            xb_add(&bar[XB_XGEN(b.x)], 1u);
            asm volatile("s_waitcnt vmcnt(0)" ::: "memory");
        } else {
            XB_SPIN(xb_ld(&bar[XB_XGEN(b.x)]) == gen, bar);
            __builtin_amdgcn_fence(__ATOMIC_ACQUIRE, "agent");
            asm volatile("s_waitcnt vmcnt(0)" ::: "memory");
        }
    }
    __syncthreads();
}


__global__ __launch_bounds__(512) void mega_fwd(Params p) {
    extern __shared__ __attribute__((aligned(16))) unsigned char smem[];
    LAS unsigned char* lds = (LAS unsigned char*)smem;
    unsigned char* ws = p.ws;
    const float* ada = (const float*)(ws + WS_ADA);
    volatile LAS unsigned* xst = (volatile LAS unsigned*)(lds + 147456);
    if (threadIdx.x < 4) xst[threadIdx.x] = 0u;
    __syncthreads();
    const XcdBarrier xbar = xcd_barrier_post((unsigned*)(ws + WS_BAR), xst);
    if (p.ph_hi == 12345) cg::this_grid().sync();
#define GRID_SYNC() xcd_barrier(xbar)
    if (p.ph_lo <= 0 && 0 < p.ph_hi) {
        if (0 > p.ph_lo) { GRID_SYNC(); }
        if (EN(0)) phase_ada(p, smem);
    }
    asm volatile("" ::: "memory");
    if (p.ph_lo <= 1 && 1 < p.ph_hi) {
        if (1 > p.ph_lo) { GRID_SYNC(); }
        if (EN(1)) {
            phase_prep_rest(p, smem);
            const int lane = threadIdx.x & 63, wave = threadIdx.x >> 6;
            const int nw = (int)gridDim.x * 8, w0 = (int)blockIdx.x * 8 + wave;
            for (int row = w0; row < MTOK + MCTX; row += 4 * nw) {
                const float* xs[4]; const u16* ds[4]; u16* os[4]; u16* hs[4]; bool ok[4];
#pragma unroll
                for (int q = 0; q < 4; ++q) { const int r = row + q * nw; ok[q] = r < MTOK + MCTX; ds[q] = nullptr; os[q] = r < MTOK ? (u16*)(ws + WS_X1B) + (size_t)r * 1024 : nullptr;
                    xs[q] = r < MTOK ? p.in[0] + (size_t)r * 1024 : p.in[2] + (size_t)(r - MTOK) * 1024;
                    hs[q] = r < MTOK ? (u16*)(ws + WS_HX) + (size_t)r * 1024 : (u16*)(ws + WS_HC) + (size_t)(r - MTOK) * 1024; }
                const int b = row < MTOK ? (row >> 13) : 4;
                if (nw == 2048) rows4<false>(xs, ds, os, hs, ok, p.in[6], ada + b * 6144, ada + b * 6144 + 1024, lane);
                else { for (int q = 0; q < 4; ++q) { const int r = row + q * nw; if (r < MTOK + MCTX) { const int b2 = r < MTOK ? (r >> 13) : 4; const bool o1[4] = {true, false, false, false};
                    const float* x1[4] = {xs[q], xs[q], xs[q], xs[q]}; u16* h1[4] = {hs[q], hs[q], hs[q], hs[q]}; u16* oo[4] = {os[q], os[q], os[q], os[q]}; rows4<false>(x1, ds, oo, h1, o1, p.in[6], ada + b2 * 6144, ada + b2 * 6144 + 1024, lane); } } }
            }
            }
    }
    asm volatile("" ::: "memory");
    if (p.ph_lo <= 2 && 2 < p.ph_hi) {
        if (2 > p.ph_lo) { GRID_SYNC(); }
        if (EN(2)) {
            EpiWin E; E.ws = ws; E.xl = lds + 131072;
            run_gemm2(lds, (const u16*)(ws + WS_HX), (const u16*)(ws + WS_WIN), MTOK, 2048, (const u16*)(ws + WS_HC), (const u16*)(ws + WS_WIN) + (size_t)1024 * 1024, 0, 256, 1024, E);
            }
    }
    asm volatile("" ::: "memory");
    if (p.ph_lo <= 3 && 3 < p.ph_hi) {
        if (3 > p.ph_lo) { GRID_SYNC(); }
        if (EN(3)) {
            const int nctx = gridDim.x > 32 ? 16 : 0;
            if ((int)blockIdx.x >= nctx) phase_fft1(p, smem, (int)blockIdx.x - nctx, (int)gridDim.x - nctx);
            EpiWin E; E.ws = ws; E.xl = lds + 131072;
            run_gemm2(lds, (const u16*)(ws + WS_HX), (const u16*)(ws + WS_WIN), 0, 256, (const u16*)(ws + WS_HC), (const u16*)(ws + WS_WIN) + (size_t)1024 * 1024, MCTX, 1024, 1024, E);
            }
    }
    asm volatile("" ::: "memory");
    if (p.ph_lo <= 4 && 4 < p.ph_hi) {
        if (4 > p.ph_lo) { GRID_SYNC(); }
        if (EN(4)) phase_fft2(p, smem); if (EN(41)) phase_attn(p, lds);
#if defined(PROBE_X) && PROBE_X == 41
        GRID_SYNC(); phase_attn(p, lds);
#endif
#if defined(PROBE_X) && PROBE_X == 42
        GRID_SYNC(); phase_fft2(p, smem);
#endif
    }
    asm volatile("" ::: "memory");
    if (p.ph_lo <= 5 && 5 < p.ph_hi) {
        if (5 > p.ph_lo) { GRID_SYNC(); }
        if (EN(5)) {
            EpiFused E; E.G = (u16*)(ws + WS_GATES); E.O = (u16*)(ws + WS_MERGED);
            pg8::Gemm g; g.A = (const u16*)(ws + WS_HX); g.Bt = (const u16*)(ws + WS_WGATE); g.A2 = g.A; g.Bt2 = g.Bt; g.M = MTOK; g.N = 1024; g.K = 1024; g.M2 = 0; g.N2 = 0; g.KL = 512;
            pg8::FusedOrder S; S.G = (int)gridDim.x; S.c = (int)blockIdx.x; S.ws = (const char*)ws;
            pg8::gemm_phase<EpiFused, pg8::FusedOrder, false>(lds, g, S, E, nullptr);
            }
    }
    asm volatile("" ::: "memory");
    if (p.ph_lo <= 7 && 7 < p.ph_hi) {
        if (7 > p.ph_lo) { GRID_SYNC(); }
        if (EN(7)) {
            auto prestep = [&]() {
                const u16* W1 = (const u16*)(ws + WS_W1); u16* W1P = (u16*)(ws + WS_W1P); float* CB = (float*)(ws + WS_CB);
                const int gt = (int)blockIdx.x * 512 + (int)threadIdx.x, nt = (int)gridDim.x * 512;
                for (int i = gt; i < 4096 * 128; i += nt) {
                    const int n = i >> 7, k0 = (i & 127) * 8; const u32x4 w = *(const u32x4*)(W1 + (size_t)n * 1024 + k0);
                    const float4 g0 = *(const float4*)(p.in[7] + k0), g1 = *(const float4*)(p.in[7] + k0 + 4);
#pragma unroll
                    for (int bb = 0; bb < 4; ++bb) { const float* sc = ada + bb * 6144 + 4096 + k0; const float4 s0 = *(const float4*)sc, s1 = *(const float4*)(sc + 4);
                        float v[8] = {bflo(w[0]) * g0.x * (1.f + s0.x), bfhi(w[0]) * g0.y * (1.f + s0.y), bflo(w[1]) * g0.z * (1.f + s0.z), bfhi(w[1]) * g0.w * (1.f + s0.w),
                                      bflo(w[2]) * g1.x * (1.f + s1.x), bfhi(w[2]) * g1.y * (1.f + s1.y), bflo(w[3]) * g1.z * (1.f + s1.z), bfhi(w[3]) * g1.w * (1.f + s1.w)};
                        *(u32x4*)(W1P + (size_t)bb * (4u << 20) + (size_t)n * 1024 + k0) = pack8(v); } }
                const int lane = threadIdx.x & 63, gw = (int)blockIdx.x * 8 + ((int)threadIdx.x >> 6), nw = (int)gridDim.x * 8;
                for (int o0 = gw; o0 < 4 * 4096; o0 += 4 * nw) {
                    u32x4 wq[4][2]; float4 hq[4][2][2]; bool okq[4];
#pragma unroll
                    for (int t = 0; t < 4; ++t) { const int o = o0 + t * nw; okq[t] = o < 4 * 4096; if (okq[t]) { const int bb = o >> 12, n = o & 4095;
#pragma unroll
                        for (int q = 0; q < 2; ++q) { const int k0 = (lane + 64 * q) * 8; wq[t][q] = *(const u32x4*)(W1 + (size_t)n * 1024 + k0); const float* sh = ada + bb * 6144 + 3072 + k0;
                            hq[t][q][0] = *(const float4*)sh; hq[t][q][1] = *(const float4*)(sh + 4); } } }
#pragma unroll
                    for (int t = 0; t < 4; ++t) if (okq[t]) { float s = 0.f;
#pragma unroll
                        for (int q = 0; q < 2; ++q) { const u32x4 w = wq[t][q]; const float4 h0 = hq[t][q][0], h1 = hq[t][q][1];
                            s += bflo(w[0]) * h0.x + bfhi(w[0]) * h0.y + bflo(w[1]) * h0.z + bfhi(w[1]) * h0.w + bflo(w[2]) * h1.x + bfhi(w[2]) * h1.y + bflo(w[3]) * h1.z + bfhi(w[3]) * h1.w; }
                        s = wave_sum(s); if (lane == 0) CB[o0 + t * nw] = s; } }
            };
            const bool pre_first = (((int)blockIdx.x >> 3) & 1) == 0;
            if (pre_first) prestep();
            EpiX1 E; E.X = (u16*)(ws + WS_X1B); E.gate = ada + 2048; E.SSP = (float*)(ws + WS_SSP);
            run_gemm(lds, (const u16*)(ws + WS_MERGED), (const u16*)(ws + WS_WO), MTOK, 1024, 1024, E);
            if (!pre_first) prestep();
            }
    }
    asm volatile("" ::: "memory");
    if (p.ph_lo <= 9 && 9 < p.ph_hi) {
        if (9 > p.ph_lo) { GRID_SYNC(); }
        if (EN(9)) {
            EpiMlp1 E; E.O = (u16*)(ws + WS_A); E.SSP = (const float*)(ws + WS_RSTD); E.CB = (const float*)(ws + WS_CB);
            {
                pg8::BatchBOrder S0; S0.init(MTOK, 4096, 0, 256, (int)gridDim.x, (int)blockIdx.x); pg8::Unit uu; const float* ssp = (const float*)(ws + WS_SSP); float* rst = (float*)(ws + WS_RSTD);
                for (int i = 0; S0.next(i, uu); ++i) { if (threadIdx.x < 256) { const int r = uu.pm * 256 + (int)threadIdx.x; const f32x4* sp = (const f32x4*)(ssp + (size_t)r * 16); const f32x4 s0 = sp[0], s1 = sp[1], s2 = sp[2], s3 = sp[3];
                    const float s = ((s0[0] + s0[1]) + (s0[2] + s0[3])) + ((s1[0] + s1[1]) + (s1[2] + s1[3])) + ((s2[0] + s2[1]) + (s2[2] + s2[3])) + ((s3[0] + s3[1]) + (s3[2] + s3[3]));
                    rst[r] = __builtin_amdgcn_rsqf(s * (1.f / 1024.f) + 1e-6f); } }
                __threadfence_block(); __syncthreads();
            }
            pg8::Gemm g; g.A = (const u16*)(ws + WS_X1B); g.Bt = (const u16*)(ws + WS_W1P); g.A2 = g.A; g.Bt2 = g.Bt; g.M = MTOK; g.N = 4096; g.K = 1024; g.M2 = 0; g.N2 = 256; g.KL = 0;
            pg8::BatchBOrder S; S.init(MTOK, 4096, 0, 256, (int)gridDim.x, (int)blockIdx.x);
            pg8::gemm_phase<EpiMlp1, pg8::BatchBOrder, false>(lds, g, S, E, nullptr);
            }
    }
    asm volatile("" ::: "memory");
    if (p.ph_lo <= 10 && 10 < p.ph_hi) {
        if (10 > p.ph_lo) { GRID_SYNC(); }
        if (EN(10)) {
            EpiResid E; E.base = (const u16*)(ws + WS_X1B); E.out = p.out; E.gate = ada + 5120;
#if defined(PROBE_X) && PROBE_X == 10
            { EpiBf16<0> X; X.O = (u16*)(ws + WS_HX); X.ldc = 1024; run_gemm(lds, (const u16*)(ws + WS_A), (const u16*)(ws + WS_W2), MTOK, 1024, 4096, X); } GRID_SYNC();
#endif
            run_gemm(lds, (const u16*)(ws + WS_A), (const u16*)(ws + WS_W2), MTOK, 1024, 4096, E);
            }
    }
    asm volatile("" ::: "memory");
#if defined(PROBE_X) && PROBE_X == 99
    if (p.ph_hi - p.ph_lo > 1) { for (int i = 0; i < 10; ++i) GRID_SYNC(); }
#endif
}

extern "C" void kernel_launch(void* const* d_in, const int* in_sizes, int n_in, void* d_out, int out_size, void* d_ws, size_t ws_size, hipStream_t stream) {
    static int grid = 0;
    if (grid == 0) {
        if (n_in != 18 || ws_size < WS_END) { fprintf(stderr, "kernel_launch: unexpected inputs (n_in %d, ws %zu)\n", n_in, ws_size); grid = -1; return; }
        int dev = 0, cus = 0, per_cu = 0;
        hipGetDevice(&dev); hipDeviceGetAttribute(&cus, hipDeviceAttributeMultiprocessorCount, dev);
        if (hipFuncSetAttribute((const void*)mega_fwd, hipFuncAttributeMaxDynamicSharedMemorySize, LDS_BYTES) != hipSuccess) { fprintf(stderr, "kernel_launch: hipFuncSetAttribute failed\n"); grid = -1; return; }
        hipOccupancyMaxActiveBlocksPerMultiprocessor(&per_cu, (const void*)mega_fwd, 512, LDS_BYTES);
        (void)hipGetLastError();
        if (per_cu < 1) per_cu = 1;
        grid = cus * 1;
        if (grid <= 0) grid = 256;
    }
    if (grid < 0) return;
    Params p{};
    for (int i = 0; i < 18; ++i) p.in[i] = (const float*)d_in[i];
    p.out = (float*)d_out; p.ws = (unsigned char*)d_ws;
#if N_LAUNCH_MODE == 0
    hipMemsetAsync((unsigned char*)d_ws + WS_BAR, 0, XCD_BAR_WORDS * 4, stream);
    p.ph_lo = 0; p.ph_hi = N_PHASES;
    void* args[] = {&p};
    hipError_t e = hipLaunchCooperativeKernel((const void*)mega_fwd, dim3(grid), dim3(512), args, LDS_BYTES, stream);
    if (e != hipSuccess) fprintf(stderr, "cooperative launch failed: %s (grid %d)\n", hipGetErrorString(e), grid);
#else
    for (int ph = 0; ph < N_PHASES; ++ph) { p.ph_lo = ph; p.ph_hi = ph + 1; hipLaunchKernelGGL(mega_fwd, dim3(grid), dim3(512), LDS_BYTES, stream, p); }
#endif
}
```
